# Optimizing an MI355X kernel written in HIP

```python
import math
import jax
import jax.numpy as jnp
from jax import lax
import numpy as np

D_MODEL = 2048
BATCH = 4
SEQ = 2048
DEPTH = 2

PLE_DIM = 256
ROPE_THETA = 500000.0
NORM_EPS = 1e-6
ATTN_BLOCK = 128

CONV_DIM = 448
CONV_K = 3

SSM_DIM = 448
SSM_GROUP = 16
SSM_GROUPS = SSM_DIM // SSM_GROUP
SSM_STATE = 64

DIL_HEAD_DIM = 64
DIL_ROT = DIL_HEAD_DIM // 4
DIL_PATTERNS = ((128, 1), (512, 4), (2048, 16))
DIL_HEADS_PER_GROUP = 3
DIL_HEADS = DIL_HEADS_PER_GROUP * len(DIL_PATTERNS)
DIL_DIM = DIL_HEADS * DIL_HEAD_DIM

MLA_HEADS = 9
MLA_Q_RANK = 384
MLA_KV_RANK = 256
MLA_NOPE = 64
MLA_ROPE = 32
MLA_V = 64
MLA_QK = MLA_NOPE + MLA_ROPE
MLA_DIM = MLA_HEADS * MLA_V

D_MIX = CONV_DIM + SSM_DIM + DIL_DIM + MLA_DIM
IN_SPLITS = (CONV_DIM, CONV_DIM, CONV_DIM, SSM_DIM, DIL_DIM, DIL_DIM, DIL_DIM, MLA_Q_RANK, MLA_KV_RANK, MLA_ROPE)
D_IN = sum(IN_SPLITS)

MOE_GROUPS = 8
MOE_EPG = 8
N_EXPERTS = MOE_GROUPS * MOE_EPG
MOE_TOPK = 2
MOE_FF = 512
MOE_BLOCK = 128

kernel_name = 'hymba_style_hybrid_hmoe_trunk'


def rmsnorm(x, g):
    xf = x.astype(jnp.float32)
    y = xf * lax.rsqrt(jnp.mean(xf * xf, axis=-1, keepdims=True) + NORM_EPS)
    return (y * g.astype(jnp.float32)).astype(x.dtype)


def rope_cos_sin(positions, rot_dim):
    inv_freq = ROPE_THETA ** (-jnp.arange(0, rot_dim, 2, dtype=jnp.float32) / rot_dim)
    ang = positions.astype(jnp.float32)[..., None] * inv_freq
    return jnp.cos(ang), jnp.sin(ang)


def apply_rope(x, cos, sin):
    half = cos.shape[-1]
    c = cos[:, :, None, :].astype(x.dtype)
    s = sin[:, :, None, :].astype(x.dtype)
    x1 = x[..., :half]
    x2 = x[..., half:2 * half]
    return jnp.concatenate([x1 * c - x2 * s, x2 * c + x1 * s, x[..., 2 * half:]], axis=-1)


def short_conv_mixer(b, c, h, conv_w):
    u = c * h
    y = lax.conv_general_dilated(u, conv_w[:, None, :].astype(u.dtype), window_strides=(1,),
                                 padding=((CONV_K - 1, 0),), dimension_numbers=('NWC', 'WIO', 'NWC'),
                                 feature_group_count=CONV_DIM)
    return b * y


def s5_mixer(u, lam_re, lam_im, log_dt, b_re, b_im, c_re, c_im, d_skip, glu_w, glu_b):
    Bn, S, _ = u.shape
    f32 = jnp.float32
    uf = u.astype(f32)
    ug = uf.reshape(Bn, S, SSM_GROUPS, SSM_GROUP)
    lr = lam_re.astype(f32)
    li = lam_im.astype(f32)
    dt = jnp.exp(log_dt.astype(f32))[:, None]
    mag = jnp.exp(lr * dt)
    lbar_re = mag * jnp.cos(li * dt)
    lbar_im = mag * jnp.sin(li * dt)
    nr = lbar_re - 1.0
    ni = lbar_im
    den = lr * lr + li * li
    f_re = (nr * lr + ni * li) / den
    f_im = (ni * lr - nr * li) / den
    bu_re = jnp.einsum('bsgc,gpc->bsgp', ug, b_re.astype(f32))
    bu_im = jnp.einsum('bsgc,gpc->bsgp', ug, b_im.astype(f32))
    in_re = f_re * bu_re - f_im * bu_im
    in_im = f_re * bu_im + f_im * bu_re
    a_re = jnp.broadcast_to(lbar_re, in_re.shape)
    a_im = jnp.broadcast_to(lbar_im, in_im.shape)

    def combine(e1, e2):
        a1r, a1i, b1r, b1i = e1
        a2r, a2i, b2r, b2i = e2
        return (a2r * a1r - a2i * a1i, a2r * a1i + a2i * a1r,
                a2r * b1r - a2i * b1i + b2r, a2r * b1i + a2i * b1r + b2i)

    _, _, xr, xi = lax.associative_scan(combine, (a_re, a_im, in_re, in_im), axis=1)
    y = (jnp.einsum('bsgp,gcp->bsgc', xr, c_re.astype(f32))
         - jnp.einsum('bsgp,gcp->bsgc', xi, c_im.astype(f32)))
    y = y.reshape(Bn, S, SSM_DIM) + d_skip.astype(f32) * uf
    g = jax.nn.gelu(y)
    out = g * jax.nn.sigmoid(g @ glu_w.astype(f32) + glu_b.astype(f32))
    return out.astype(u.dtype)


def banded_causal_attention(q, k, v, steps):
    N, L, H, hd = q.shape
    blk = steps
    nb = -(-L // blk)
    Lp = nb * blk
    pad = Lp - L
    scale = 1.0 / math.sqrt(hd)
    qp = jnp.pad(q, ((0, 0), (0, pad), (0, 0), (0, 0)))
    kp = jnp.pad(k, ((0, 0), (blk, pad), (0, 0), (0, 0)))
    vp = jnp.pad(v, ((0, 0), (blk, pad), (0, 0), (0, 0)))
    qb = qp.reshape(N, nb, blk, H, hd)
    kb = jnp.concatenate([kp[:, :Lp].reshape(N, nb, blk, H, hd), kp[:, blk:].reshape(N, nb, blk, H, hd)], axis=2)
    vb = jnp.concatenate([vp[:, :Lp].reshape(N, nb, blk, H, hd), vp[:, blk:].reshape(N, nb, blk, H, hd)], axis=2)
    s = jnp.einsum('nbqhd,nbkhd->nbhqk', qb, kb).astype(jnp.float32) * scale
    qi = jnp.arange(blk)[:, None]
    ki = jnp.arange(2 * blk)[None, :]
    dist = qi + blk - ki
    key_abs = jnp.arange(nb)[:, None, None] * blk - blk + ki[None]
    valid = (dist >= 0)[None] & (dist <= steps)[None] & (key_abs >= 0)
    s = jnp.where(valid[None, :, None], s, -jnp.inf)
    lse = jax.nn.logsumexp(s, axis=-1)
    pr = jnp.exp(s - lse[..., None]).astype(v.dtype)
    o = jnp.einsum('nbhqk,nbkhd->nbqhd', pr, vb).reshape(N, Lp, H, hd)[:, :L]
    lse = lse.transpose(0, 1, 3, 2).reshape(N, Lp, H)[:, :L]
    return o, lse


def dilated_group_attention(q, k, v, dil, steps):
    Bn, S, H, hd = q.shape
    L = S // dil

    def to_res(t):
        return t.reshape(Bn, L, dil, H, hd).transpose(0, 2, 1, 3, 4).reshape(Bn * dil, L, H, hd)

    o, lse = banded_causal_attention(to_res(q), to_res(k), to_res(v), steps)
    o = o.reshape(Bn, dil, L, H, hd).transpose(0, 2, 1, 3, 4).reshape(Bn, S, H, hd)
    lse = lse.reshape(Bn, dil, L, H).transpose(0, 2, 1, 3).reshape(Bn, S, H)
    return o, lse


def dilated_mixer(q, k, v, cos, sin):
    Bn, S, _ = q.shape
    q = apply_rope(q.reshape(Bn, S, DIL_HEADS, DIL_HEAD_DIM), cos, sin)
    k = apply_rope(k.reshape(Bn, S, DIL_HEADS, DIL_HEAD_DIM), cos, sin)
    v = v.reshape(Bn, S, DIL_HEADS, DIL_HEAD_DIM)
    outs = []
    lses = []
    for g, (window, dil) in enumerate(DIL_PATTERNS):
        sl = slice(g * DIL_HEADS_PER_GROUP, (g + 1) * DIL_HEADS_PER_GROUP)
        o, lse = dilated_group_attention(q[:, :, sl], k[:, :, sl], v[:, :, sl], dil, window // dil)
        outs.append(o)
        lses.append(lse)
    alpha = jax.nn.softmax(jnp.stack(lses, axis=0), axis=0)
    o = jnp.stack(outs, axis=0) * alpha[..., None].astype(q.dtype)
    return o.transpose(1, 2, 0, 3, 4).reshape(Bn, S, DIL_DIM)


def causal_attention_blocks(q, k, v):
    Bn, S, H, dq = q.shape
    nb = S // ATTN_BLOCK
    scale = 1.0 / math.sqrt(dq)
    qb = q.reshape(Bn, nb, ATTN_BLOCK, H, dq).transpose(1, 0, 2, 3, 4)
    kpos = jnp.arange(S)

    def one_block(args):
        qblk, i = args
        s = jnp.einsum('bqhd,bkhd->bhqk', qblk, k).astype(jnp.float32) * scale
        qpos = i * ATTN_BLOCK + jnp.arange(ATTN_BLOCK)
        s = jnp.where(kpos[None, :] <= qpos[:, None], s, -jnp.inf)
        pr = jax.nn.softmax(s, axis=-1).astype(v.dtype)
        return jnp.einsum('bhqk,bkhd->bqhd', pr, v)

    o = lax.map(one_block, (qb, jnp.arange(nb)))
    return o.transpose(1, 0, 2, 3, 4).reshape(Bn, S, H, v.shape[-1])


def mla_mixer(cq, ckv, k_rope, q_norm_g, w_uq, kv_norm_g, w_ukv, cos, sin):
    Bn, S, _ = cq.shape
    q = (rmsnorm(cq, q_norm_g) @ w_uq).reshape(Bn, S, MLA_HEADS, MLA_QK)
    kv = (rmsnorm(ckv, kv_norm_g) @ w_ukv).reshape(Bn, S, MLA_HEADS, MLA_NOPE + MLA_V)
    q = jnp.concatenate([q[..., :MLA_NOPE], apply_rope(q[..., MLA_NOPE:], cos, sin)], axis=-1)
    kr = apply_rope(k_rope[:, :, None, :], cos, sin)
    k = jnp.concatenate([kv[..., :MLA_NOPE], jnp.broadcast_to(kr, (Bn, S, MLA_HEADS, MLA_ROPE))], axis=-1)
    v = kv[..., MLA_NOPE:]
    return causal_attention_blocks(q, k, v).reshape(Bn, S, MLA_DIM)


def hierarchical_moe(h, w_group, b_group, w_router, b_router, w_gate, w_up, w_down):
    T, D = h.shape
    g_logits = (h @ w_group).astype(jnp.float32) + b_group.astype(jnp.float32)
    g_prob = jax.nn.softmax(g_logits, axis=-1)
    g_top_p, g_top_i = lax.top_k(g_prob, 1)
    e_logits = ((h @ w_router).astype(jnp.float32) + b_router.astype(jnp.float32)).reshape(T, MOE_GROUPS, MOE_EPG)
    e_in = e_logits[jnp.arange(T), g_top_i[:, 0]]
    e_top_v, e_top_i = lax.top_k(e_in, MOE_TOPK)
    gates = jax.nn.softmax(e_top_v, axis=-1) * g_top_p
    expert_idx = g_top_i * MOE_EPG + e_top_i

    A = T * MOE_TOPK
    nblk = (A + N_EXPERTS * (MOE_BLOCK - 1) + MOE_BLOCK - 1) // MOE_BLOCK
    P = nblk * MOE_BLOCK
    flat_e = expert_idx.reshape(-1).astype(jnp.int32)
    order = jnp.argsort(flat_e)
    sorted_e = flat_e[order]
    tok = order // MOE_TOPK
    counts = jnp.bincount(flat_e, length=N_EXPERTS)
    padded = ((counts + MOE_BLOCK - 1) // MOE_BLOCK) * MOE_BLOCK
    pend = jnp.cumsum(padded)
    pstart = pend - padded
    start = jnp.cumsum(counts) - counts
    dest = pstart[sorted_e] + (jnp.arange(A) - start[sorted_e])
    buf_tok = jnp.zeros((P,), jnp.int32).at[dest].set(tok.astype(jnp.int32))
    block_expert = jnp.minimum(jnp.searchsorted(pend, jnp.arange(nblk) * MOE_BLOCK, side='right'), N_EXPERTS - 1)
    xb = h[buf_tok].reshape(nblk, MOE_BLOCK, D)

    def one_block(args):
        xblk, e = args
        return (jax.nn.silu(xblk @ w_gate[e]) * (xblk @ w_up[e])) @ w_down[e]

    yb = lax.map(one_block, (xb, block_expert)).reshape(P, D)
    contrib = yb[dest] * gates.reshape(-1)[order][:, None].astype(h.dtype)
    return jnp.zeros((T, D), h.dtype).at[tok].add(contrib)


def setup_inputs(seed: int = 0) -> dict:
    key = jax.random.key(seed)
    ks = iter(list(jax.random.split(key, 40)))
    f32 = jnp.float32

    def nrm(shape, scale):
        return jax.random.normal(next(ks), shape, f32) * scale

    def gain(shape):
        return 1.0 + 0.02 * jax.random.normal(next(ks), shape, f32)

    x = nrm((BATCH, SEQ, D_MODEL), 1.0)
    p = nrm((DEPTH, BATCH, SEQ, PLE_DIM), 1.0)
    positions = (jnp.arange(SEQ, dtype=jnp.int32)[None, :]
                 + jax.random.randint(next(ks), (BATCH, 1), 0, 1024, dtype=jnp.int32))
    norm_mix_g = gain((DEPTH, D_MODEL))
    w_in = nrm((DEPTH, D_MODEL, D_IN), D_MODEL ** -0.5)
    conv_w = nrm((DEPTH, CONV_K, CONV_DIM), CONV_K ** -0.5)
    ssm_lam_re = -0.5 * jnp.exp(nrm((DEPTH, SSM_GROUPS, SSM_STATE), 0.05))
    ssm_lam_im = math.pi * jnp.arange(SSM_STATE, dtype=f32) + nrm((DEPTH, SSM_GROUPS, SSM_STATE), 0.05)
    ssm_log_dt = jax.random.uniform(next(ks), (DEPTH, SSM_GROUPS), f32, math.log(1e-3), math.log(1e-1))
    ssm_b_re = nrm((DEPTH, SSM_GROUPS, SSM_STATE, SSM_GROUP), (2 * SSM_GROUP) ** -0.5)
    ssm_b_im = nrm((DEPTH, SSM_GROUPS, SSM_STATE, SSM_GROUP), (2 * SSM_GROUP) ** -0.5)
    ssm_c_re = nrm((DEPTH, SSM_GROUPS, SSM_GROUP, SSM_STATE), (2 * SSM_STATE) ** -0.5)
    ssm_c_im = nrm((DEPTH, SSM_GROUPS, SSM_GROUP, SSM_STATE), (2 * SSM_STATE) ** -0.5)
    ssm_d = nrm((DEPTH, SSM_DIM), 1.0)
    ssm_glu_w = nrm((DEPTH, SSM_DIM, SSM_DIM), SSM_DIM ** -0.5)
    ssm_glu_b = nrm((DEPTH, SSM_DIM), 0.02)
    mla_q_norm_g = gain((DEPTH, MLA_Q_RANK))
    mla_w_uq = nrm((DEPTH, MLA_Q_RANK, MLA_HEADS * MLA_QK), MLA_Q_RANK ** -0.5)
    mla_kv_norm_g = gain((DEPTH, MLA_KV_RANK))
    mla_w_ukv = nrm((DEPTH, MLA_KV_RANK, MLA_HEADS * (MLA_NOPE + MLA_V)), MLA_KV_RANK ** -0.5)
    w_out = nrm((DEPTH, D_MIX, D_MODEL), D_MIX ** -0.5)
    norm_ffn_g = gain((DEPTH, D_MODEL))
    w_group = nrm((DEPTH, D_MODEL, MOE_GROUPS), D_MODEL ** -0.5)
    b_group = nrm((DEPTH, MOE_GROUPS), 0.01)
    w_router = nrm((DEPTH, D_MODEL, N_EXPERTS), D_MODEL ** -0.5)
    b_router = nrm((DEPTH, N_EXPERTS), 0.01)
    moe_w_gate = nrm((DEPTH, N_EXPERTS, D_MODEL, MOE_FF), D_MODEL ** -0.5)
    moe_w_up = nrm((DEPTH, N_EXPERTS, D_MODEL, MOE_FF), D_MODEL ** -0.5)
    moe_w_down = nrm((DEPTH, N_EXPERTS, MOE_FF, D_MODEL), MOE_FF ** -0.5)
    norm_ple_g = gain((DEPTH, D_MODEL))
    ple_w_proj = nrm((DEPTH, PLE_DIM, D_MODEL), PLE_DIM ** -0.5)
    ple_w_gate = nrm((DEPTH, D_MODEL, D_MODEL), D_MODEL ** -0.5)
    final_norm_g = gain((D_MODEL,))
    return {'x': x, 'p': p, 'positions': positions, 'norm_mix_g': norm_mix_g, 'w_in': w_in,
            'conv_w': conv_w, 'ssm_lam_re': ssm_lam_re, 'ssm_lam_im': ssm_lam_im, 'ssm_log_dt': ssm_log_dt,
            'ssm_b_re': ssm_b_re, 'ssm_b_im': ssm_b_im, 'ssm_c_re': ssm_c_re, 'ssm_c_im': ssm_c_im,
            'ssm_d': ssm_d, 'ssm_glu_w': ssm_glu_w, 'ssm_glu_b': ssm_glu_b,
            'mla_q_norm_g': mla_q_norm_g, 'mla_w_uq': mla_w_uq, 'mla_kv_norm_g': mla_kv_norm_g,
            'mla_w_ukv': mla_w_ukv, 'w_out': w_out, 'norm_ffn_g': norm_ffn_g,
            'w_group': w_group, 'b_group': b_group, 'w_router': w_router, 'b_router': b_router,
            'moe_w_gate': moe_w_gate, 'moe_w_up': moe_w_up, 'moe_w_down': moe_w_down,
            'norm_ple_g': norm_ple_g, 'ple_w_proj': ple_w_proj, 'ple_w_gate': ple_w_gate,
            'final_norm_g': final_norm_g}


def reference(x, p, positions, norm_mix_g, w_in, conv_w, ssm_lam_re, ssm_lam_im, ssm_log_dt,
              ssm_b_re, ssm_b_im, ssm_c_re, ssm_c_im, ssm_d, ssm_glu_w, ssm_glu_b,
              mla_q_norm_g, mla_w_uq, mla_kv_norm_g, mla_w_ukv, w_out, norm_ffn_g,
              w_group, b_group, w_router, b_router, moe_w_gate, moe_w_up, moe_w_down,
              norm_ple_g, ple_w_proj, ple_w_gate, final_norm_g):
    Bn, S, D = x.shape
    cos_d, sin_d = rope_cos_sin(positions, DIL_ROT)
    cos_m, sin_m = rope_cos_sin(positions, MLA_ROPE)
    split_at = list(np.cumsum(IN_SPLITS)[:-1])
    h = x
    for i in range(DEPTH):
        hn = rmsnorm(h, norm_mix_g[i])
        z = hn @ w_in[i]
        cb, cc, ch, su, dq, dk, dv, mcq, mckv, mkr = jnp.split(z, split_at, axis=-1)
        y_conv = short_conv_mixer(cb, cc, ch, conv_w[i])
        y_ssm = s5_mixer(su, ssm_lam_re[i], ssm_lam_im[i], ssm_log_dt[i], ssm_b_re[i], ssm_b_im[i],
                         ssm_c_re[i], ssm_c_im[i], ssm_d[i], ssm_glu_w[i], ssm_glu_b[i])
        y_dil = dilated_mixer(dq, dk, dv, cos_d, sin_d)
        y_mla = mla_mixer(mcq, mckv, mkr, mla_q_norm_g[i], mla_w_uq[i], mla_kv_norm_g[i], mla_w_ukv[i], cos_m, sin_m)
        mix = jnp.concatenate([y_conv, y_ssm, y_dil, y_mla], axis=-1) @ w_out[i]
        h = h + mix
        hn = rmsnorm(h, norm_ffn_g[i])
        ffn = hierarchical_moe(hn.reshape(Bn * S, D), w_group[i], b_group[i], w_router[i], b_router[i],
                               moe_w_gate[i], moe_w_up[i], moe_w_down[i])
        h = h + ffn.reshape(Bn, S, D)
        hn = rmsnorm(h, norm_ple_g[i])
        h = h + (p[i].astype(h.dtype) @ ple_w_proj[i]) * jax.nn.sigmoid(hn @ ple_w_gate[i])
    return rmsnorm(h, final_norm_g)
```

```cpp
#include <hip/hip_runtime.h>
#include <stdint.h>

namespace {
constexpr int NB = 4, S = 2048, D = 2048, T = NB * S, DEPTH = 2, PLE = 256, DIN = 4192;
constexpr int CONVD = 448, SSMD = 448, NG = 28, NP = 64, DILD = 576, MLAD = 576;
constexpr int OFF_CB = 0, OFF_CC = 448, OFF_CH = 896, OFF_SU = 1344, OFF_DQ = 1792, OFF_DK = 2368, OFF_DV = 2944,
              OFF_CQ = 3520, OFF_CKV = 3904, OFF_KR = 4160;
constexpr int QR = 384, KVR = 256, NQ = 864, NKV = 1152;
constexpr int NE = 64, FF = 512, PSLOT = 20480, NTILE = PSLOT / 64;
constexpr float EPS = 1e-6f;

struct GemmP {
    const float* A; int lda; const int* rowidx;
    const float* B; int ldb; const int* tile_e; long estride;
    float* C; int ldc; int M, N, K;
    const float* aux; int ldaux; const float* bias;
};
template <int EPI>
__global__ __launch_bounds__(256) void k_gemm(GemmP p) {
    __shared__ float As[16][68];
    __shared__ float Bs[16][68];
    const int tm = blockIdx.y, tn = blockIdx.x, tid = threadIdx.x;
    const float* B = p.B;
    if (p.tile_e) { const int e = p.tile_e[tm]; if (e < 0) return; B += (long)e * p.estride; }
    const int tx = tid & 15, ty = tid >> 4;
    const int arow = tid >> 2, ak = (tid & 3) * 4;
    const int gm = tm * 64 + arow;
    const long ar = p.rowidx ? (long)p.rowidx[gm] : (long)gm;
    const float* Ap = p.A + ar * p.lda + ak;
    const int bk = tid >> 4, bn = (tid & 15) * 4;
    const int gn = tn * 64 + bn;
    float acc[4][4];
#pragma unroll
    for (int i = 0; i < 4; ++i)
#pragma unroll
        for (int j = 0; j < 4; ++j) acc[i][j] = 0.f;
    for (int k0 = 0; k0 < p.K; k0 += 16) {
        const float4 a = *(const float4*)(Ap + k0);
        float4 b = make_float4(0.f, 0.f, 0.f, 0.f);
        if (gn < p.N) b = *(const float4*)(B + (long)(k0 + bk) * p.ldb + gn);
        __syncthreads();
        As[ak + 0][arow] = a.x; As[ak + 1][arow] = a.y; As[ak + 2][arow] = a.z; As[ak + 3][arow] = a.w;
        *(float4*)&Bs[bk][bn] = b;
        __syncthreads();
#pragma unroll
        for (int kk = 0; kk < 16; ++kk) {
            const float4 av = *(const float4*)&As[kk][ty * 4];
            const float4 bv = *(const float4*)&Bs[kk][tx * 4];
            const float aa[4] = {av.x, av.y, av.z, av.w};
            const float bb[4] = {bv.x, bv.y, bv.z, bv.w};
#pragma unroll
            for (int i = 0; i < 4; ++i)
#pragma unroll
                for (int j = 0; j < 4; ++j) acc[i][j] = fmaf(aa[i], bb[j], acc[i][j]);
        }
    }
#pragma unroll
    for (int i = 0; i < 4; ++i) {
        const long row = (long)tm * 64 + ty * 4 + i;
#pragma unroll
        for (int j = 0; j < 4; ++j) {
            const int col = tn * 64 + tx * 4 + j;
            if (col < p.N) {
                float* c = p.C + row * p.ldc + col;
                const float v = acc[i][j];
                if (EPI == 0) *c = v;
                else if (EPI == 1) *c += v;
                else if (EPI == 2) { const float g = p.aux[row * p.ldaux + col]; *c = (g / (1.f + expf(-g))) * v; }
                else if (EPI == 3) { const float pr = p.aux[row * p.ldaux + col]; *c += pr * (1.f / (1.f + expf(-v))); }
                else if (EPI == 4) { const float gv = p.aux[row * p.ldaux + col]; *c = gv * (1.f / (1.f + expf(-(v + p.bias[col])))); }
            }
        }
    }
}

__global__ __launch_bounds__(256) void k_rmsnorm(const float* in, int ld_in, const float* g, float* out, int ld_out, int n) {
    __shared__ float red[4];
    const long r = blockIdx.x;
    const float* x = in + r * ld_in;
    float s = 0.f;
    for (int i = threadIdx.x; i < n; i += 256) { const float v = x[i]; s += v * v; }
    for (int o = 32; o > 0; o >>= 1) s += __shfl_xor(s, o);
    if ((threadIdx.x & 63) == 0) red[threadIdx.x >> 6] = s;
    __syncthreads();
    s = red[0] + red[1] + red[2] + red[3];
    const float rs = 1.0f / sqrtf(s / (float)n + EPS);
    for (int i = threadIdx.x; i < n; i += 256) out[r * ld_out + i] = x[i] * rs * g[i];
}

__device__ inline void sincos_d(double a, double& s, double& c) {
    const double k = rint(a * 0.15915494309189535);
    double r = fma(-k, 6.283185307179586, a);
    r = fma(-k, 2.4492935982947064e-16, r);
    const double r2 = r * r;
    double ss = 0.0, cc = 0.0;
#pragma unroll
    for (int n = 14; n >= 1; --n) {
        ss = (ss + 1.0) * (-r2 / (double)((2 * n) * (2 * n + 1)));
        cc = (cc + 1.0) * (-r2 / (double)((2 * n - 1) * (2 * n)));
    }
    s = r * (1.0 + ss);
    c = 1.0 + cc;
}
__global__ void k_rope_tab(const int* pos, float* cd, float* sd, float* cm, float* sm) {
    const int i = blockIdx.x * blockDim.x + threadIdx.x;
    if (i >= T * 24) return;
    const int t = i / 24, j = i % 24;
    const double LN_THETA = 13.122363377404328;
    double s, c;
    if (j < 8) {
        const double f = exp(-(double)j / 8.0 * LN_THETA);
        sincos_d((double)pos[t] * f, s, c);
        cd[t * 8 + j] = (float)c; sd[t * 8 + j] = (float)s;
    } else {
        const int jj = j - 8;
        const double f = exp(-(double)jj / 16.0 * LN_THETA);
        sincos_d((double)pos[t] * f, s, c);
        cm[t * 16 + jj] = (float)c; sm[t * 16 + jj] = (float)s;
    }
}

__global__ void k_conv(const float* z, const float* cw, float* mix) {
    const int i = blockIdx.x * blockDim.x + threadIdx.x;
    if (i >= T * CONVD) return;
    const int t = i / CONVD, c = i % CONVD, s = t % S;
    const float* zr = z + (long)t * DIN;
    float y = cw[2 * CONVD + c] * zr[OFF_CC + c] * zr[OFF_CH + c];
    if (s >= 1) { const float* z1 = zr - DIN; y += cw[1 * CONVD + c] * z1[OFF_CC + c] * z1[OFF_CH + c]; }
    if (s >= 2) { const float* z2 = zr - 2 * DIN; y += cw[0 * CONVD + c] * z2[OFF_CC + c] * z2[OFF_CH + c]; }
    mix[(long)t * D + c] = zr[OFF_CB + c] * y;
}

__global__ __launch_bounds__(64) void k_ssm_scan(const float* z, const float* lam_re, const float* lam_im, const float* log_dt,
                                                 const float* b_re, const float* b_im, float* X) {
    const int b = blockIdx.x / NG, g = blockIdx.x % NG, p = threadIdx.x;
    const float lr = lam_re[g * NP + p], li = lam_im[g * NP + p];
    const float dt = expf(log_dt[g]);
    const float mag = expf(lr * dt);
    const float ar = mag * cosf(li * dt), ai = mag * sinf(li * dt);
    const float nr = ar - 1.f, ni = ai, den = lr * lr + li * li;
    const float fr = (nr * lr + ni * li) / den, fi = (ni * lr - nr * li) / den;
    float br[16], bi[16];
#pragma unroll
    for (int c = 0; c < 16; ++c) { br[c] = b_re[(g * NP + p) * 16 + c]; bi[c] = b_im[(g * NP + p) * 16 + c]; }
    float xr = 0.f, xi = 0.f;
    const float* zu = z + (long)b * S * DIN + OFF_SU + g * 16;
    for (int t = 0; t < S; ++t) {
        const float4* up = (const float4*)(zu + (long)t * DIN);
        const float4 u0 = up[0], u1 = up[1], u2 = up[2], u3 = up[3];
        const float u[16] = {u0.x, u0.y, u0.z, u0.w, u1.x, u1.y, u1.z, u1.w, u2.x, u2.y, u2.z, u2.w, u3.x, u3.y, u3.z, u3.w};
        float sr = 0.f, si = 0.f;
#pragma unroll
        for (int c = 0; c < 16; ++c) { sr = fmaf(u[c], br[c], sr); si = fmaf(u[c], bi[c], si); }
        const float ir = fr * sr - fi * si, ii = fr * si + fi * sr;
        const float nxr = ar * xr - ai * xi + ir, nxi = ar * xi + ai * xr + ii;
        xr = nxr; xi = nxi;
        float* xo = X + ((long)(b * S + t) * NG + g) * 128;
        xo[p] = xr; xo[64 + p] = xi;
    }
}
__device__ inline float gelu_tanh(float x) {
    const float k = 0.7978845608028654f;
    return 0.5f * x * (1.f + tanhf(k * (x + 0.044715f * x * x * x)));
}
__global__ void k_ssm_out(const float* z, const float* X, const float* c_re, const float* c_im, const float* dsk, float* gv) {
    const int i = blockIdx.x * blockDim.x + threadIdx.x;
    if (i >= T * SSMD) return;
    const int t = i / SSMD, ch = i % SSMD, g = ch / 16, c = ch % 16;
    const float* x = X + ((long)t * NG + g) * 128;
    const float* cr = c_re + (g * 16 + c) * NP;
    const float* ci = c_im + (g * 16 + c) * NP;
    float y = 0.f;
    for (int p = 0; p < NP; ++p) y += x[p] * cr[p] - x[64 + p] * ci[p];
    y += dsk[ch] * z[(long)t * DIN + OFF_SU + ch];
    gv[(long)t * SSMD + ch] = gelu_tanh(y);
}

__global__ void k_rope_dil(const float* z, const float* cd, const float* sd, float* qd, float* kd) {
    const int i = blockIdx.x * blockDim.x + threadIdx.x;
    if (i >= T * DILD) return;
    const int t = i / DILD, col = i % DILD, d = col & 63, hb = col - d;
    const float* zq = z + (long)t * DIN + OFF_DQ + hb;
    const float* zk = z + (long)t * DIN + OFF_DK + hb;
    float q, k;
    if (d < 8) { const float c = cd[t * 8 + d], s = sd[t * 8 + d]; q = zq[d] * c - zq[d + 8] * s; k = zk[d] * c - zk[d + 8] * s; }
    else if (d < 16) { const float c = cd[t * 8 + d - 8], s = sd[t * 8 + d - 8]; q = zq[d] * c + zq[d - 8] * s; k = zk[d] * c + zk[d - 8] * s; }
    else { q = zq[d]; k = zk[d]; }
    qd[i] = q; kd[i] = k;
}
__global__ __launch_bounds__(256) void k_dil_attn(const float* qd, const float* kd, const float* z, float* od, float* lse) {
    const int i = blockIdx.x * 256 + threadIdx.x;
    const int head = i / T, t = i % T, s = t % S;
    const int g = head / 3, dil = (g == 0) ? 1 : (g == 1 ? 4 : 16);
    float q[64], o[64];
    const float4* qp = (const float4*)(qd + (long)t * DILD + head * 64);
#pragma unroll
    for (int j = 0; j < 16; ++j) { const float4 v = qp[j]; q[4 * j] = v.x; q[4 * j + 1] = v.y; q[4 * j + 2] = v.z; q[4 * j + 3] = v.w; }
#pragma unroll
    for (int j = 0; j < 64; ++j) o[j] = 0.f;
    float mx = -INFINITY, l = 0.f;
    for (int m = 0; m <= 128; ++m) {
        const int sp = s - m * dil;
        if (sp < 0) break;
        const long tk = (long)(t - m * dil);
        const float4* kp = (const float4*)(kd + tk * DILD + head * 64);
        float dot = 0.f;
#pragma unroll
        for (int j = 0; j < 16; ++j) { const float4 v = kp[j]; dot += q[4 * j] * v.x + q[4 * j + 1] * v.y + q[4 * j + 2] * v.z + q[4 * j + 3] * v.w; }
        dot *= 0.125f;
        const float nm = fmaxf(mx, dot);
        const float corr = expf(mx - nm), pw = expf(dot - nm);
        l = l * corr + pw;
        const float4* vp = (const float4*)(z + tk * DIN + OFF_DV + head * 64);
#pragma unroll
        for (int j = 0; j < 16; ++j) { const float4 v = vp[j];
            o[4 * j] = o[4 * j] * corr + pw * v.x; o[4 * j + 1] = o[4 * j + 1] * corr + pw * v.y;
            o[4 * j + 2] = o[4 * j + 2] * corr + pw * v.z; o[4 * j + 3] = o[4 * j + 3] * corr + pw * v.w; }
        mx = nm;
    }
    const float inv = 1.f / l;
    float4* op = (float4*)(od + (long)t * DILD + head * 64);
#pragma unroll
    for (int j = 0; j < 16; ++j) op[j] = make_float4(o[4 * j] * inv, o[4 * j + 1] * inv, o[4 * j + 2] * inv, o[4 * j + 3] * inv);
    lse[(long)t * 9 + head] = mx + logf(l);
}
__global__ void k_dil_combine(const float* od, const float* lse, float* mix) {
    const int i = blockIdx.x * blockDim.x + threadIdx.x;
    if (i >= T * DILD) return;
    const int t = i / DILD, col = i % DILD, head = col >> 6, g = head / 3, hg = head % 3;
    const float l0 = lse[(long)t * 9 + hg], l1 = lse[(long)t * 9 + 3 + hg], l2 = lse[(long)t * 9 + 6 + hg];
    const float m = fmaxf(l0, fmaxf(l1, l2));
    const float e0 = expf(l0 - m), e1 = expf(l1 - m), e2 = expf(l2 - m);
    const float eg = (g == 0) ? e0 : (g == 1 ? e1 : e2);
    mix[(long)t * D + 896 + col] = od[i] * eg / (e0 + e1 + e2);
}

__global__ void k_mla_prep(const float* qm, const float* z, const float* cm, const float* sm, float* qf, float* krf) {
    const int i = blockIdx.x * blockDim.x + threadIdx.x;
    if (i >= T * (NQ + 32)) return;
    const int t = i / (NQ + 32), c = i % (NQ + 32);
    if (c < NQ) {
        const int h = c / 96, d = c % 96;
        const float* q = qm + (long)t * NQ + h * 96;
        float v;
        if (d < 64) v = q[d];
        else if (d < 80) { const int j = d - 64; v = q[64 + j] * cm[t * 16 + j] - q[80 + j] * sm[t * 16 + j]; }
        else { const int j = d - 80; v = q[80 + j] * cm[t * 16 + j] + q[64 + j] * sm[t * 16 + j]; }
        qf[(long)t * NQ + c] = v;
    } else {
        const int d = c - NQ;
        const float* k = z + (long)t * DIN + OFF_KR;
        float v;
        if (d < 16) v = k[d] * cm[t * 16 + d] - k[d + 16] * sm[t * 16 + d];
        else { const int j = d - 16; v = k[d] * cm[t * 16 + j] + k[j] * sm[t * 16 + j]; }
        krf[(long)t * 32 + d] = v;
    }
}
__global__ __launch_bounds__(256) void k_mla_attn(const float* qf, const float* kvm, const float* krf, float* mix) {
    const int s = blockIdx.x * 256 + threadIdx.x, h = blockIdx.y, b = blockIdx.z;
    const long t = (long)b * S + s;
    float q[96], o[64];
    const float4* qp = (const float4*)(qf + t * NQ + h * 96);
#pragma unroll
    for (int j = 0; j < 24; ++j) { const float4 v = qp[j]; q[4 * j] = v.x; q[4 * j + 1] = v.y; q[4 * j + 2] = v.z; q[4 * j + 3] = v.w; }
#pragma unroll
    for (int j = 0; j < 64; ++j) o[j] = 0.f;
    float mx = -INFINITY, l = 0.f;
    const float scale = 0.10206207261596575f;
    for (int sk = 0; sk <= s; ++sk) {
        const long tk = (long)b * S + sk;
        const float4* kp = (const float4*)(kvm + tk * NKV + h * 128);
        const float4* rp = (const float4*)(krf + tk * 32);
        float dot = 0.f;
#pragma unroll
        for (int j = 0; j < 16; ++j) { const float4 v = kp[j]; dot += q[4 * j] * v.x + q[4 * j + 1] * v.y + q[4 * j + 2] * v.z + q[4 * j + 3] * v.w; }
#pragma unroll
        for (int j = 0; j < 8; ++j) { const float4 v = rp[j]; dot += q[64 + 4 * j] * v.x + q[65 + 4 * j] * v.y + q[66 + 4 * j] * v.z + q[67 + 4 * j] * v.w; }
        dot *= scale;
        const float nm = fmaxf(mx, dot);
        const float corr = expf(mx - nm), pw = expf(dot - nm);
        l = l * corr + pw;
        const float4* vp = kp + 16;
#pragma unroll
        for (int j = 0; j < 16; ++j) { const float4 v = vp[j];
            o[4 * j] = o[4 * j] * corr + pw * v.x; o[4 * j + 1] = o[4 * j + 1] * corr + pw * v.y;
            o[4 * j + 2] = o[4 * j + 2] * corr + pw * v.z; o[4 * j + 3] = o[4 * j + 3] * corr + pw * v.w; }
        mx = nm;
    }
    const float inv = 1.f / l;
    float4* op = (float4*)(mix + t * D + 1472 + h * 64);
#pragma unroll
    for (int j = 0; j < 16; ++j) op[j] = make_float4(o[4 * j] * inv, o[4 * j + 1] * inv, o[4 * j + 2] * inv, o[4 * j + 3] * inv);
}

__global__ __launch_bounds__(128) void k_router(const float* hn, const float* wg, const float* bg, const float* wr, const float* br,
                                                int* eidx, float* gate, int* cnt) {
    __shared__ float row[D];
    __shared__ float lg[72];
    const int t = blockIdx.x, j = threadIdx.x;
    for (int i = j; i < D; i += 128) row[i] = hn[(long)t * D + i];
    __syncthreads();
    if (j < 72) {
        float acc = 0.f;
        if (j < 8) { for (int k = 0; k < D; ++k) acc = fmaf(row[k], wg[k * 8 + j], acc); acc += bg[j]; }
        else { const int jj = j - 8; for (int k = 0; k < D; ++k) acc = fmaf(row[k], wr[k * 64 + jj], acc); acc += br[jj]; }
        lg[j] = acc;
    }
    __syncthreads();
    if (j == 0) {
        int gi = 0; float mx = lg[0];
        for (int i = 1; i < 8; ++i) if (lg[i] > mx) { mx = lg[i]; gi = i; }
        float sum = 0.f;
        for (int i = 0; i < 8; ++i) sum += expf(lg[i] - mx);
        const float gp = 1.f / sum;
        const float* e = lg + 8 + gi * 8;
        int i1 = 0; float v1 = e[0];
        for (int i = 1; i < 8; ++i) if (e[i] > v1) { v1 = e[i]; i1 = i; }
        int i2 = -1; float v2 = -INFINITY;
        for (int i = 0; i < 8; ++i) if (i != i1 && e[i] > v2) { v2 = e[i]; i2 = i; }
        const float e2 = expf(v2 - v1);
        const float a1 = 1.f / (1.f + e2), a2 = e2 / (1.f + e2);
        eidx[t * 2] = gi * 8 + i1; eidx[t * 2 + 1] = gi * 8 + i2;
        gate[t * 2] = a1 * gp; gate[t * 2 + 1] = a2 * gp;
        atomicAdd(&cnt[gi * 8 + i1], 1); atomicAdd(&cnt[gi * 8 + i2], 1);
    }
}
__global__ __launch_bounds__(256) void k_moe_offsets(const int* cnt, int* pstart, int* cursor, int* tile_e, int* slot_tok) {
    __shared__ int ps[NE + 1];
    if (threadIdx.x == 0) {
        int acc = 0;
        for (int e = 0; e < NE; ++e) { ps[e] = acc; acc += ((cnt[e] + 63) / 64) * 64; }
        ps[NE] = acc;
    }
    __syncthreads();
    if (threadIdx.x <= NE) pstart[threadIdx.x] = ps[threadIdx.x];
    if (threadIdx.x < NE) cursor[threadIdx.x] = 0;
    for (int i = threadIdx.x; i < NTILE; i += 256) {
        const int r = i * 64; int e = -1;
        if (r < ps[NE]) { for (int k = 0; k < NE; ++k) if (r >= ps[k] && r < ps[k + 1]) e = k; }
        tile_e[i] = e;
    }
    for (int i = threadIdx.x; i < PSLOT; i += 256) slot_tok[i] = 0;
}
__global__ void k_moe_scatter(const int* eidx, const int* pstart, int* cursor, int* slot_tok, int* tok_slot) {
    const int a = blockIdx.x * blockDim.x + threadIdx.x;
    if (a >= T * 2) return;
    const int e = eidx[a];
    const int pos = atomicAdd(&cursor[e], 1);
    const int slot = pstart[e] + pos;
    slot_tok[slot] = a >> 1;
    tok_slot[a] = slot;
}
__global__ void k_moe_combine(float* h, const float* Y, const int* tok_slot, const float* gate) {
    const long i = (long)blockIdx.x * blockDim.x + threadIdx.x;
    if (i >= (long)T * D) return;
    const int t = (int)(i / D), c = (int)(i % D);
    const int s0 = tok_slot[t * 2], s1 = tok_slot[t * 2 + 1];
    h[i] += gate[t * 2] * Y[(long)s0 * D + c] + gate[t * 2 + 1] * Y[(long)s1 * D + c];
}
}

template <int EPI>
static void gemm(hipStream_t st, GemmP p) {
    dim3 grid((p.N + 63) / 64, p.M / 64);
    k_gemm<EPI><<<grid, 256, 0, st>>>(p);
}

extern "C" void kernel_launch(void* const* d_in, const int* in_sizes, int n_in, void* d_out, int out_size, void* d_ws, size_t ws_size,
                              hipStream_t stream) {
    const float* x = (const float*)d_in[0];
    const float* pin = (const float*)d_in[1];
    const int* pos = (const int*)d_in[2];
    auto F = [&](int i) { return (const float*)d_in[i]; };
    float* out = (float*)d_out;

    char* w = (char*)d_ws;
    size_t off = 0;
    auto alloc = [&](size_t bytes) { void* p = w + off; off += (bytes + 255) & ~(size_t)255; return p; };
    float* h = (float*)alloc((size_t)T * D * 4);
    float* hn = (float*)alloc((size_t)T * D * 4);
    float* z = (float*)alloc((size_t)T * DIN * 4);
    float* mix = (float*)alloc((size_t)T * D * 4);
    float* nq = (float*)alloc((size_t)T * QR * 4);
    float* nkv = (float*)alloc((size_t)T * KVR * 4);
    float* qm = (float*)alloc((size_t)T * NQ * 4);
    float* kvm = (float*)alloc((size_t)T * NKV * 4);
    float* qf = (float*)alloc((size_t)T * NQ * 4);
    float* krf = (float*)alloc((size_t)T * 32 * 4);
    float* qd = (float*)alloc((size_t)T * DILD * 4);
    float* kd = (float*)alloc((size_t)T * DILD * 4);
    float* od = (float*)alloc((size_t)T * DILD * 4);
    float* lse = (float*)alloc((size_t)T * 9 * 4);
    float* X = (float*)alloc((size_t)T * NG * 128 * 4);
    float* gv = (float*)alloc((size_t)T * SSMD * 4);
    float* cd = (float*)alloc((size_t)T * 8 * 4);
    float* sd = (float*)alloc((size_t)T * 8 * 4);
    float* cm = (float*)alloc((size_t)T * 16 * 4);
    float* sm = (float*)alloc((size_t)T * 16 * 4);
    float* pproj = (float*)alloc((size_t)T * D * 4);
    int* eidx = (int*)alloc((size_t)T * 2 * 4);
    float* gate = (float*)alloc((size_t)T * 2 * 4);
    int* cnt = (int*)alloc(256);
    int* cursor = (int*)alloc(256);
    int* pstart = (int*)alloc(512);
    int* tile_e = (int*)alloc(NTILE * 4);
    int* slot_tok = (int*)alloc(PSLOT * 4);
    int* tok_slot = (int*)alloc((size_t)T * 2 * 4);
    float* G = (float*)alloc((size_t)PSLOT * FF * 4);
    float* act = (float*)alloc((size_t)PSLOT * FF * 4);
    float* Y = (float*)alloc((size_t)PSLOT * D * 4);

    hipMemcpyAsync(h, x, (size_t)T * D * 4, hipMemcpyDeviceToDevice, stream);
    k_rope_tab<<<(T * 24 + 255) / 256, 256, 0, stream>>>(pos, cd, sd, cm, sm);

    for (int L = 0; L < DEPTH; ++L) {
        const float* norm_mix_g = F(3) + (size_t)L * D;
        const float* w_in = F(4) + (size_t)L * D * DIN;
        const float* conv_w = F(5) + (size_t)L * 3 * CONVD;
        const float* lam_re = F(6) + (size_t)L * NG * NP;
        const float* lam_im = F(7) + (size_t)L * NG * NP;
        const float* log_dt = F(8) + (size_t)L * NG;
        const float* b_re = F(9) + (size_t)L * NG * NP * 16;
        const float* b_im = F(10) + (size_t)L * NG * NP * 16;
        const float* c_re = F(11) + (size_t)L * NG * 16 * NP;
        const float* c_im = F(12) + (size_t)L * NG * 16 * NP;
        const float* ssm_d = F(13) + (size_t)L * SSMD;
        const float* glu_w = F(14) + (size_t)L * SSMD * SSMD;
        const float* glu_b = F(15) + (size_t)L * SSMD;
        const float* q_norm_g = F(16) + (size_t)L * QR;
        const float* w_uq = F(17) + (size_t)L * QR * NQ;
        const float* kv_norm_g = F(18) + (size_t)L * KVR;
        const float* w_ukv = F(19) + (size_t)L * KVR * NKV;
        const float* w_out = F(20) + (size_t)L * D * D;
        const float* norm_ffn_g = F(21) + (size_t)L * D;
        const float* w_group = F(22) + (size_t)L * D * 8;
        const float* b_group = F(23) + (size_t)L * 8;
        const float* w_router = F(24) + (size_t)L * D * NE;
        const float* b_router = F(25) + (size_t)L * NE;
        const float* w_gate = F(26) + (size_t)L * NE * D * FF;
        const float* w_up = F(27) + (size_t)L * NE * D * FF;
        const float* w_down = F(28) + (size_t)L * NE * FF * D;
        const float* norm_ple_g = F(29) + (size_t)L * D;
        const float* ple_w_proj = F(30) + (size_t)L * PLE * D;
        const float* ple_w_gate = F(31) + (size_t)L * D * D;
        const float* pl = pin + (size_t)L * T * PLE;

        k_rmsnorm<<<T, 256, 0, stream>>>(h, D, norm_mix_g, hn, D, D);
        { GemmP p{}; p.A = hn; p.lda = D; p.B = w_in; p.ldb = DIN; p.C = z; p.ldc = DIN; p.M = T; p.N = DIN; p.K = D; gemm<0>(stream, p); }
        k_conv<<<(T * CONVD + 255) / 256, 256, 0, stream>>>(z, conv_w, mix);
        k_ssm_scan<<<NB * NG, 64, 0, stream>>>(z, lam_re, lam_im, log_dt, b_re, b_im, X);
        k_ssm_out<<<(T * SSMD + 255) / 256, 256, 0, stream>>>(z, X, c_re, c_im, ssm_d, gv);
        { GemmP p{}; p.A = gv; p.lda = SSMD; p.B = glu_w; p.ldb = SSMD; p.C = mix + 448; p.ldc = D; p.M = T; p.N = SSMD; p.K = SSMD;
          p.aux = gv; p.ldaux = SSMD; p.bias = glu_b; gemm<4>(stream, p); }
        k_rope_dil<<<(T * DILD + 255) / 256, 256, 0, stream>>>(z, cd, sd, qd, kd);
        k_dil_attn<<<(T * 9) / 256, 256, 0, stream>>>(qd, kd, z, od, lse);
        k_dil_combine<<<(T * DILD + 255) / 256, 256, 0, stream>>>(od, lse, mix);
        k_rmsnorm<<<T, 256, 0, stream>>>(z + OFF_CQ, DIN, q_norm_g, nq, QR, QR);
        k_rmsnorm<<<T, 256, 0, stream>>>(z + OFF_CKV, DIN, kv_norm_g, nkv, KVR, KVR);
        { GemmP p{}; p.A = nq; p.lda = QR; p.B = w_uq; p.ldb = NQ; p.C = qm; p.ldc = NQ; p.M = T; p.N = NQ; p.K = QR; gemm<0>(stream, p); }
        { GemmP p{}; p.A = nkv; p.lda = KVR; p.B = w_ukv; p.ldb = NKV; p.C = kvm; p.ldc = NKV; p.M = T; p.N = NKV; p.K = KVR; gemm<0>(stream, p); }
        k_mla_prep<<<(T * (NQ + 32) + 255) / 256, 256, 0, stream>>>(qm, z, cm, sm, qf, krf);
        k_mla_attn<<<dim3(S / 256, 9, NB), 256, 0, stream>>>(qf, kvm, krf, mix);
        { GemmP p{}; p.A = mix; p.lda = D; p.B = w_out; p.ldb = D; p.C = h; p.ldc = D; p.M = T; p.N = D; p.K = D; gemm<1>(stream, p); }

        k_rmsnorm<<<T, 256, 0, stream>>>(h, D, norm_ffn_g, hn, D, D);
        hipMemsetAsync(cnt, 0, 256, stream);
        k_router<<<T, 128, 0, stream>>>(hn, w_group, b_group, w_router, b_router, eidx, gate, cnt);
        k_moe_offsets<<<1, 256, 0, stream>>>(cnt, pstart, cursor, tile_e, slot_tok);
        k_moe_scatter<<<(T * 2 + 255) / 256, 256, 0, stream>>>(eidx, pstart, cursor, slot_tok, tok_slot);
        { GemmP p{}; p.A = hn; p.lda = D; p.rowidx = slot_tok; p.B = w_gate; p.ldb = FF; p.tile_e = tile_e; p.estride = (long)D * FF;
          p.C = G; p.ldc = FF; p.M = PSLOT; p.N = FF; p.K = D; gemm<0>(stream, p); }
        { GemmP p{}; p.A = hn; p.lda = D; p.rowidx = slot_tok; p.B = w_up; p.ldb = FF; p.tile_e = tile_e; p.estride = (long)D * FF;
          p.C = act; p.ldc = FF; p.M = PSLOT; p.N = FF; p.K = D; p.aux = G; p.ldaux = FF; gemm<2>(stream, p); }
        { GemmP p{}; p.A = act; p.lda = FF; p.B = w_down; p.ldb = D; p.tile_e = tile_e; p.estride = (long)FF * D;
          p.C = Y; p.ldc = D; p.M = PSLOT; p.N = D; p.K = FF; gemm<0>(stream, p); }
        k_moe_combine<<<(int)(((long)T * D + 255) / 256), 256, 0, stream>>>(h, Y, tok_slot, gate);

        k_rmsnorm<<<T, 256, 0, stream>>>(h, D, norm_ple_g, hn, D, D);
        { GemmP p{}; p.A = pl; p.lda = PLE; p.B = ple_w_proj; p.ldb = D; p.C = pproj; p.ldc = D; p.M = T; p.N = D; p.K = PLE; gemm<0>(stream, p); }
        { GemmP p{}; p.A = hn; p.lda = D; p.B = ple_w_gate; p.ldb = D; p.C = h; p.ldc = D; p.M = T; p.N = D; p.K = D;
          p.aux = pproj; p.ldaux = D; gemm<3>(stream, p); }
    }
    k_rmsnorm<<<T, 256, 0, stream>>>(h, D, F(32), out, D, D);
}
```

```cpp
#include <hip/hip_runtime.h>
#include <stdint.h>
#include <cstdio>

#define XB_TMO      128
#define XB_XCNT(j)  (256  + 64 * (j))
#define XB_XSUB(j)  (1280 + 64 * (j))
#define XB_XGEN(j)  (2304 + 64 * (j))
#define XB_TOP      3328
#define XB_TOPGEN   3392
#define XCD_BAR_WORDS 3456
#define XB_SPIN_CAP (1u << 22)
#define LAS __attribute__((address_space(3)))

__device__ __forceinline__ unsigned xb_ld(unsigned* p)              { return __hip_atomic_load(p, __ATOMIC_RELAXED, __HIP_MEMORY_SCOPE_AGENT); }
__device__ __forceinline__ unsigned xb_add(unsigned* p, unsigned v) { return __hip_atomic_fetch_add(p, v, __ATOMIC_RELAXED, __HIP_MEMORY_SCOPE_AGENT); }
__device__ __forceinline__ unsigned xb_xcc_id() { return (unsigned)__builtin_amdgcn_s_getreg((3 << 11) | 20) & 0xFu; }
#define XB_SPIN(cond, bar) do { unsigned _sp = 0; while (cond) { __builtin_amdgcn_s_sleep(1); \
    if ((++_sp & 255u) == 0u) { if (xb_ld(&(bar)[XB_TMO])) break; if (_sp > XB_SPIN_CAP) { atomicAdd(&(bar)[XB_TMO], 1u); break; } } } } while (0)

struct XcdBarrier { unsigned* bar; unsigned x; volatile LAS unsigned* st; };

__device__ __forceinline__ XcdBarrier xcd_barrier_post(unsigned* bar, volatile LAS unsigned* st, const int tid) {
    XcdBarrier b; b.bar = bar; b.x = xb_xcc_id(); b.st = st;
    if (tid == 0) (void)xb_add(&bar[XB_XCNT(b.x)], 1u);
    return b;
}
__device__ __forceinline__ void xcd_barrier_complete(unsigned* bar, unsigned x, unsigned& nloc, unsigned& nx) {
    const unsigned G = gridDim.x * gridDim.y * gridDim.z;
    unsigned sum, cnt, mine, sp = 0u;
    for (;;) {
        sum = 0u; cnt = 0u; mine = 0u;
#pragma unroll
        for (unsigned j = 0; j < 16; ++j) { const unsigned c = xb_ld(&bar[XB_XCNT(j)]); sum += c; cnt += (c > 0u) ? 1u : 0u; mine = (j == x) ? c : mine; }
        if (sum == G) break;
        __builtin_amdgcn_s_sleep(1);
        if ((++sp & 255u) == 0u) { if (xb_ld(&bar[XB_TMO])) break; if (sp > XB_SPIN_CAP) { atomicAdd(&bar[XB_TMO], 1u); break; } }
    }
    nloc = mine > 0u ? mine : 1u; nx = cnt > 0u ? cnt : 1u;
}
__device__ __forceinline__ void xcd_barrier(const XcdBarrier& b, const int tid) {
    asm volatile("s_waitcnt vmcnt(0)" ::: "memory");
    __syncthreads();
    if (tid == 0) {
        unsigned* bar = b.bar;
        __builtin_amdgcn_s_waitcnt(0);
        unsigned nloc = b.st[0], nx = b.st[1];
        if (nloc == 0u) { xcd_barrier_complete(bar, b.x, nloc, nx); b.st[0] = nloc; b.st[1] = nx; }
        const unsigned old = xb_add(&bar[XB_XSUB(b.x)], 1u);
        const unsigned gen = old / nloc;
        if (old + 1u == (gen + 1u) * nloc) {
            __builtin_amdgcn_fence(__ATOMIC_RELEASE, "agent");
            asm volatile("s_waitcnt vmcnt(0)" ::: "memory");
            const unsigned og = xb_add(&bar[XB_TOP], 1u);
            const unsigned tg = og / nx;
            if (og + 1u == (tg + 1u) * nx) xb_add(&bar[XB_TOPGEN], 1u);
            else XB_SPIN(xb_ld(&bar[XB_TOPGEN]) == tg, bar);
            __builtin_amdgcn_fence(__ATOMIC_ACQUIRE, "agent");
            xb_add(&bar[XB_XGEN(b.x)], 1u);
            asm volatile("s_waitcnt vmcnt(0)" ::: "memory");
        } else {
            XB_SPIN(xb_ld(&bar[XB_XGEN(b.x)]) == gen, bar);
            __builtin_amdgcn_fence(__ATOMIC_ACQUIRE, "agent");
            asm volatile("s_waitcnt vmcnt(0)" ::: "memory");
        }
    }
    __syncthreads();
}

namespace pg8 {
#define PG8_LAS __attribute__((address_space(3)))
typedef unsigned short bf16_t;
typedef short bf16x8 __attribute__((ext_vector_type(8)));
typedef float f32x4 __attribute__((ext_vector_type(4)));
typedef unsigned u32x4 __attribute__((ext_vector_type(4)));
constexpr int BM = 256, BK = 64, HALF = 128, HTB = HALF * BK * 2  , STAGE_BYTES = 8 * HTB, NXCD = 8, WGM = 8;

__host__ __device__ __forceinline__ int lds_byte(int r, int c) { const int st = (r >> 4) * 2 + (c >> 5), rr = r & 15, cc = c & 31, ob = rr * 64 + cc * 2; return st * 1024 + (ob ^ (((ob >> 9) & 1) << 5)); }
__host__ __device__ __forceinline__ void stage_rc(int b, int& R, int& C) { const int st = b / 1024, sb = b % 1024, swz = sb ^ (((sb >> 9) & 1) << 5); R = (st >> 1) * 16 + swz / 64; C = (st & 1) * 32 + (swz % 64) / 2; }
__host__ __device__ __forceinline__ int perm32(int rho) { const int n = rho >> 4, i = rho & 15; return 8 * (i >> 2) + 4 * n + (i & 3); }

struct Unit { int pm, pn; };
struct Gemm { const bf16_t* A; const bf16_t* Bt; int M, N, K, lda, ldb; };

struct StaticOrder {
    int nM, nN, nwg, G, c;
    __host__ __device__ void init(int M, int N, int G_, int c_) { nM = M / BM; nN = N / BM; nwg = nM * nN; G = G_; c = c_; }
    __host__ __device__ bool next(int i, Unit& u) const {
        const long L = (long)i * G + c; if (L >= nwg) return false;
        int wgid = (int)L; { const int q = nwg / NXCD, r = nwg % NXCD, xcd = wgid % NXCD, off = wgid / NXCD; wgid = (xcd < r ? xcd * (q + 1) : r * (q + 1) + (xcd - r) * q) + off; }
        const int nig = WGM * nN, gid = wgid / nig, fm = gid * WGM, gsz = (nM - fm) < WGM ? (nM - fm) : WGM;
        u.pm = fm + ((wgid % nig) % gsz); u.pn = (wgid % nig) / gsz; return true;
    }
    __device__ __forceinline__ void a_ready(const Unit&) const {}
    __device__ __forceinline__ void done(const Unit&) const {}
};

__device__ __forceinline__ unsigned cvt_pk_bf16(float lo, float hi) { unsigned r; asm volatile("v_cvt_pk_bf16_f32 %0, %1, %2" : "=v"(r) : "v"(lo), "v"(hi)); return r; }
template <class Epi, class Sched, bool ALIGN_EPI = false, bool SP2 = false>
__device__ __forceinline__ void gemm_phase(const int tid_in, PG8_LAS unsigned char* lds, const Gemm g, const Sched& S, const Epi& E) {
    const int tid = tid_in, wid = __builtin_amdgcn_readfirstlane(tid >> 6), lane = tid & 63, wr = wid >> 2, wc = wid & 3, fr = lane & 15, fq = lane >> 4;
    const int K = g.K, nt = K / BK;
    unsigned voffA[2], voffB[2];
#pragma unroll
    for (int i = 0; i < 2; ++i) { int R, C; stage_rc(tid * 16 + i * 8192, R, C); const int Rb = Epi::PERM ? ((R & ~31) + perm32(R & 31)) : R;
        voffA[i] = (unsigned)(R * g.lda + C) * 2u; voffB[i] = (unsigned)(Rb * g.ldb + C) * 2u; }
    const size_t kstep = (size_t)(BK * 2);
    const size_t hstepA = (size_t)HALF * g.lda * 2, hstepB = (size_t)HALF * g.ldb * 2;
    const size_t tstepA = 2 * hstepA, tstepB = 2 * hstepB;
    const unsigned ldsw = (unsigned)wid * 1024u;
    const int aoff = lds_byte(wr * 64 + fr, fq * 8), boff = lds_byte(wc * 32 + fr, fq * 8);
#define PG8_SA(b, h) (((b) * 2 + (h)) * HTB)
#define PG8_SB(b, h) ((4 + (b) * 2 + (h)) * HTB)
#define PG8_STAGE(bufoff, gbase, voff) do { _Pragma("unroll") for (int _i = 0; _i < 2; ++_i) \
        __builtin_amdgcn_global_load_lds((const unsigned*)((const char*)(gbase) + (voff)[_i]), (PG8_LAS unsigned*)(lds + (bufoff) + ldsw + _i * 8192), 16, 0, 0); } while (0)
#define PG8_LDA(dst, b, h) do { _Pragma("unroll") for (int m = 0; m < 4; ++m) _Pragma("unroll") for (int k = 0; k < 2; ++k) dst[m][k] = *(const PG8_LAS bf16x8*)(lds + PG8_SA(b, h) + aoff + m * 2048 + k * 1024); } while (0)
#define PG8_LDB(dst, b, h) do { _Pragma("unroll") for (int n = 0; n < 2; ++n) _Pragma("unroll") for (int k = 0; k < 2; ++k) dst[n][k] = *(const PG8_LAS bf16x8*)(lds + PG8_SB(b, h) + boff + n * 2048 + k * 1024); } while (0)
#define PG8_MMA(ai, bj, At, Bt) do { __builtin_amdgcn_s_setprio(1); _Pragma("unroll") for (int m = 0; m < 4; ++m) _Pragma("unroll") for (int n = 0; n < 2; ++n) _Pragma("unroll") for (int k = 0; k < 2; ++k) \
        acc[ai][bj][m][n] = __builtin_amdgcn_mfma_f32_16x16x32_bf16(Bt[n][k], At[m][k], acc[ai][bj][m][n], 0, 0, 0); __builtin_amdgcn_s_setprio(0); } while (0)
#define PG8_WAIT_V(n) asm volatile("s_waitcnt vmcnt(" #n ")" ::: "memory")
#define PG8_WAIT_L(n) asm volatile("s_waitcnt lgkmcnt(" #n ")" ::: "memory")
#define PG8_BAR __builtin_amdgcn_s_barrier()
#define PG8_SCHED __builtin_amdgcn_sched_barrier(0)
    Unit cur, nxt; int ui = 0;
    if (!S.next(0, cur)) return;
    f32x4 acc[2][2][4][2];
#pragma unroll
    for (int a = 0; a < 2; ++a)
#pragma unroll
        for (int b = 0; b < 2; ++b)
#pragma unroll
            for (int m = 0; m < 4; ++m)
#pragma unroll
                for (int n = 0; n < 2; ++n) acc[a][b][m][n] = (f32x4){0.f, 0.f, 0.f, 0.f};
    bf16x8 At[4][2], B0[2][2], B1[2][2];
    const char* cA = (const char*)g.A + (size_t)cur.pm * tstepA; const char* cB = (const char*)g.Bt + (size_t)cur.pn * tstepB;
    S.a_ready(cur);
    if constexpr (SP2) {
        PG8_STAGE(PG8_SB(0, 0), cB, voffB); PG8_STAGE(PG8_SB(0, 1), cB + hstepB, voffB); PG8_STAGE(PG8_SA(0, 0), cA, voffA); PG8_STAGE(PG8_SA(0, 1), cA + hstepA, voffA);
        if (wr == 1) PG8_BAR;
        PG8_WAIT_V(2); PG8_BAR;
        PG8_STAGE(PG8_SB(1, 0), cB + kstep, voffB); PG8_STAGE(PG8_SA(1, 0), cA + kstep, voffA); PG8_STAGE(PG8_SB(1, 1), cB + hstepB + kstep, voffB);
        PG8_WAIT_V(6); PG8_BAR;
    } else {
        PG8_STAGE(PG8_SB(0, 0), cB, voffB); PG8_STAGE(PG8_SA(0, 0), cA, voffA); PG8_STAGE(PG8_SB(0, 1), cB + hstepB, voffB); PG8_STAGE(PG8_SA(0, 1), cA + hstepA, voffA);
        if (wr == 1) PG8_BAR;
        PG8_WAIT_V(4); PG8_BAR;
        PG8_STAGE(PG8_SB(1, 0), cB + kstep, voffB); PG8_STAGE(PG8_SA(1, 0), cA + kstep, voffA); PG8_STAGE(PG8_SB(1, 1), cB + hstepB + kstep, voffB);
        PG8_WAIT_V(6); PG8_BAR;
    }
    for (;;) {
        const bool has_next = S.next(ui + 1, nxt);
        const char* nA = has_next ? (const char*)g.A + (size_t)nxt.pm * tstepA : cA; const char* nB = has_next ? (const char*)g.Bt + (size_t)nxt.pn * tstepB : cB;
        for (int t = 0; t < nt; t += 2) {
            const bool last = (t == nt - 2);
            const char* a1 = cA + (size_t)(t + 1) * kstep;
            const char* a2 = last ? nA : cA + (size_t)(t + 2) * kstep; const char* b2 = last ? nB : cB + (size_t)(t + 2) * kstep;
            const char* a3 = a2 + kstep; const char* b3 = b2 + kstep;
            if (last && has_next) S.a_ready(nxt);
            if constexpr (SP2) {
            PG8_LDB(B0, 0, 0); PG8_LDB(B1, 0, 1); PG8_SCHED; PG8_LDA(At, 0, 0); PG8_STAGE(PG8_SA(1, 1), a1 + hstepA, voffA);
            PG8_WAIT_V(8); PG8_WAIT_L(0); PG8_BAR; PG8_MMA(0, 0, At, B0); PG8_MMA(0, 1, At, B1); PG8_BAR; PG8_SCHED;
            PG8_LDA(At, 0, 1); PG8_STAGE(PG8_SB(0, 0), b2, voffB); PG8_STAGE(PG8_SB(0, 1), b2 + hstepB, voffB); PG8_STAGE(PG8_SA(0, 0), a2, voffA);
            PG8_WAIT_V(8); PG8_WAIT_L(0); PG8_BAR; PG8_MMA(1, 0, At, B0); PG8_MMA(1, 1, At, B1); PG8_BAR; PG8_SCHED;
            PG8_LDB(B0, 1, 0); PG8_LDB(B1, 1, 1); PG8_SCHED; PG8_LDA(At, 1, 0); PG8_STAGE(PG8_SA(0, 1), a2 + hstepA, voffA);
            PG8_WAIT_V(8); PG8_WAIT_L(0); PG8_BAR; PG8_MMA(0, 0, At, B0); PG8_MMA(0, 1, At, B1); PG8_BAR; PG8_SCHED;
            PG8_LDA(At, 1, 1); PG8_STAGE(PG8_SB(1, 0), b3, voffB); PG8_STAGE(PG8_SB(1, 1), b3 + hstepB, voffB); PG8_STAGE(PG8_SA(1, 0), a3, voffA);
            PG8_WAIT_V(8); PG8_WAIT_L(0); PG8_BAR; PG8_MMA(1, 0, At, B0); PG8_MMA(1, 1, At, B1); PG8_BAR; PG8_SCHED;
            } else {
            PG8_LDB(B0, 0, 0); PG8_SCHED; PG8_LDA(At, 0, 0); PG8_STAGE(PG8_SA(1, 1), a1 + hstepA, voffA);
            PG8_WAIT_L(8); PG8_BAR; PG8_WAIT_L(0); PG8_MMA(0, 0, At, B0); PG8_BAR; PG8_SCHED;
            PG8_LDB(B1, 0, 1); PG8_STAGE(PG8_SB(0, 0), b2, voffB);
            PG8_BAR; PG8_WAIT_L(0); PG8_MMA(0, 1, At, B1); PG8_BAR;
            PG8_LDA(At, 0, 1); PG8_STAGE(PG8_SA(0, 0), a2, voffA);
            PG8_BAR; PG8_WAIT_L(0); PG8_MMA(1, 0, At, B0); PG8_BAR; PG8_SCHED;
            PG8_STAGE(PG8_SB(0, 1), b2 + hstepB, voffB);
            PG8_WAIT_V(6); PG8_BAR; PG8_MMA(1, 1, At, B1); PG8_BAR;
            PG8_LDB(B0, 1, 0); PG8_SCHED; PG8_LDA(At, 1, 0); PG8_STAGE(PG8_SA(0, 1), a2 + hstepA, voffA);
            PG8_WAIT_L(8); PG8_BAR; PG8_WAIT_L(0); PG8_MMA(0, 0, At, B0); PG8_BAR; PG8_SCHED;
            PG8_LDB(B1, 1, 1); PG8_STAGE(PG8_SB(1, 0), b3, voffB);
            PG8_BAR; PG8_WAIT_L(0); PG8_MMA(0, 1, At, B1); PG8_BAR;
            PG8_LDA(At, 1, 1); PG8_STAGE(PG8_SA(1, 0), a3, voffA);
            PG8_BAR; PG8_WAIT_L(0); PG8_MMA(1, 0, At, B0); PG8_BAR; PG8_SCHED;
            PG8_STAGE(PG8_SB(1, 1), b3 + hstepB, voffB);
            PG8_WAIT_V(6); PG8_BAR; PG8_MMA(1, 1, At, B1); PG8_BAR;
            }
        }
        if constexpr (ALIGN_EPI) { if (wr == 0) PG8_BAR; }
        if constexpr (!Epi::AFTER_DRAIN) { E(acc, cur, wr, wc, fr, fq); S.done(cur); }
        if (!has_next) break;
#pragma unroll
        for (int a = 0; a < 2; ++a)
#pragma unroll
            for (int b = 0; b < 2; ++b)
#pragma unroll
                for (int m = 0; m < 4; ++m)
#pragma unroll
                    for (int n = 0; n < 2; ++n) acc[a][b][m][n] = (f32x4){0.f, 0.f, 0.f, 0.f};
        cur = nxt; cA = nA; cB = nB; ++ui;
        if constexpr (ALIGN_EPI) { if (wr == 1) PG8_BAR; }
    }
    PG8_WAIT_V(0);
    if constexpr (!ALIGN_EPI) { if (wr == 0) PG8_BAR; }
    PG8_BAR;
    if constexpr (Epi::AFTER_DRAIN) { E.fused(acc, cur, wr, wc, fr, fq, lds, wid, lane); S.done(cur); }
#undef PG8_SA
#undef PG8_SB
#undef PG8_STAGE
#undef PG8_LDA
#undef PG8_LDB
#undef PG8_MMA
#undef PG8_WAIT_V
#undef PG8_WAIT_L
#undef PG8_BAR
#undef PG8_SCHED
}
}

namespace {
constexpr int NB = 4, S = 2048, D = 2048, T = NB * S, DEPTH = 2, PLE = 256, DIN = 4192;
constexpr int CONVD = 448, SSMD = 448, NG = 28, NP = 64, DILD = 576, MLAD = 576;
constexpr int OFF_CB = 0, OFF_CC = 448, OFF_CH = 896, OFF_SU = 1344, OFF_DQ = 1792, OFF_DK = 2368, OFF_DV = 2944,
              OFF_CQ = 3520, OFF_CKV = 3904, OFF_KR = 4160;
constexpr int QR = 384, KVR = 256, NQ = 864, NKV = 1152;
constexpr int NE = 64, FF = 512, MT = 320, PSLOT = 36864, NTILE = 128;
constexpr float EPS = 1e-6f;
constexpr int GLU_P = 512;
constexpr int NTHR = 512, NBLK = 256;

typedef unsigned short bf16_t;
__device__ __forceinline__ unsigned f2bf(float f) { unsigned u = __builtin_bit_cast(unsigned, f); return (u + 0x7fffu + ((u >> 16) & 1u)) >> 16; }
__device__ __forceinline__ unsigned pk2(float lo, float hi) { unsigned r; asm("v_cvt_pk_bf16_f32 %0, %1, %2" : "=v"(r) : "v"(lo), "v"(hi)); return r; }
__device__ __forceinline__ float shflx(float v, int mask, int lane) { return __builtin_bit_cast(float, __builtin_amdgcn_ds_bpermute((lane ^ mask) << 2, __builtin_bit_cast(int, v))); }
typedef unsigned long long ssq_t;
__device__ __forceinline__ ssq_t ss_enc(float v) { return (ssq_t)(v * 4294967296.0f); }
__device__ __forceinline__ float ss_dec(ssq_t v) { return (float)v * 2.3283064365386963e-10f; }
#define GAS __attribute__((address_space(1)))
typedef unsigned u32x4_t __attribute__((ext_vector_type(4)));
typedef unsigned u32x2_t __attribute__((ext_vector_type(2)));
typedef float f32x4_t __attribute__((ext_vector_type(4)));
__device__ __forceinline__ uint4 ldg16(const GAS void* p) { const u32x4_t v = *(const GAS u32x4_t*)p; return make_uint4(v.x, v.y, v.z, v.w); }
__device__ __forceinline__ uint2 ldg8(const GAS void* p) { const u32x2_t v = *(const GAS u32x2_t*)p; return make_uint2(v.x, v.y); }
__device__ __forceinline__ float4 ldgf4(const GAS void* p) { const f32x4_t v = *(const GAS f32x4_t*)p; return make_float4(v.x, v.y, v.z, v.w); }
__device__ __forceinline__ void stg16(GAS void* p, uint4 v) { u32x4_t w; w.x = v.x; w.y = v.y; w.z = v.z; w.w = v.w; *(GAS u32x4_t*)p = w; }
__device__ __forceinline__ void stg8(GAS void* p, uint2 v) { u32x2_t w; w.x = v.x; w.y = v.y; *(GAS u32x2_t*)p = w; }
#define GTID() ((long)bid_ * NTHR + tid_)
#define GSTRIDE() ((long)NBLK * NTHR)


__device__ inline void sincos_d(double a, double& s, double& c) {
    const double k = rint(a * 0.15915494309189535);
    double r = fma(-k, 6.283185307179586, a);
    r = fma(-k, 2.4492935982947064e-16, r);
    const double r2 = r * r;
    double ss = 0.0, cc = 0.0;
#pragma unroll
    for (int n = 14; n >= 1; --n) {
        ss = (ss + 1.0) * (-r2 / (double)((2 * n) * (2 * n + 1)));
        cc = (cc + 1.0) * (-r2 / (double)((2 * n - 1) * (2 * n)));
    }
    s = r * (1.0 + ss);
    c = 1.0 + cc;
}
__device__ __forceinline__ void ph_rope_tab(const int tid_, const int bid_, const int* pos, float* cd, float* sd, float* cm, float* sm) {
    for (long i = GTID(); i < (long)T * 24; i += GSTRIDE()) {
        const int t = (int)(i / 24), j = (int)(i % 24);
        const double LN_THETA = 13.122363377404328;
        double s, c;
        if (j < 8) {
            const double f = exp(-(double)j / 8.0 * LN_THETA);
            sincos_d((double)pos[t] * f, s, c);
            cd[t * 8 + j] = (float)c; sd[t * 8 + j] = (float)s;
        } else {
            const int jj = j - 8;
            const double f = exp(-(double)jj / 16.0 * LN_THETA);
            sincos_d((double)pos[t] * f, s, c);
            cm[t * 16 + jj] = (float)c; sm[t * 16 + jj] = (float)s;
        }
    }
}


__device__ inline float gelu_tanh(float x) {
    const float k = 0.7978845608028654f;
    return 0.5f * x * (1.f + tanhf(k * (x + 0.044715f * x * x * x)));
}


constexpr int SCH = 64, NCH = S / SCH;
struct SsmCoef { float ar, ai; float cr[16], ci[16]; };
__device__ __forceinline__ void ssm_setup(SsmCoef& k, int g, int p, const float* lam_re, const float* lam_im, const float* log_dt, const float* b_re, const float* b_im) {
    const float lr = lam_re[g * NP + p], li = lam_im[g * NP + p];
    const float dt = expf(log_dt[g]);
    const float mag = expf(lr * dt);
    k.ar = mag * cosf(li * dt); k.ai = mag * sinf(li * dt);
    const float nr = k.ar - 1.f, ni = k.ai, den = lr * lr + li * li;
    const float fr = (nr * lr + ni * li) / den, fi = (ni * lr - nr * li) / den;
#pragma unroll
    for (int c4 = 0; c4 < 4; ++c4) {
        const float4 br = *(const float4*)(b_re + (g * NP + p) * 16 + 4 * c4), bi = *(const float4*)(b_im + (g * NP + p) * 16 + 4 * c4);
        k.cr[4 * c4 + 0] = fr * br.x - fi * bi.x; k.ci[4 * c4 + 0] = fr * bi.x + fi * br.x;
        k.cr[4 * c4 + 1] = fr * br.y - fi * bi.y; k.ci[4 * c4 + 1] = fr * bi.y + fi * br.y;
        k.cr[4 * c4 + 2] = fr * br.z - fi * bi.z; k.ci[4 * c4 + 2] = fr * bi.z + fi * br.z;
        k.cr[4 * c4 + 3] = fr * br.w - fi * bi.w; k.ci[4 * c4 + 3] = fr * bi.w + fi * br.w;
    }
}
#define BFLO(w) __builtin_bit_cast(float, (w) << 16)
#define BFHI(w) __builtin_bit_cast(float, (w) & 0xffff0000u)
#define SSM_STEP(up) do { const u32x4_t ua_ = *(const LAS u32x4_t*)(up), ub_ = *(const LAS u32x4_t*)((up) + 16); const uint4 u0_ = make_uint4(ua_.x, ua_.y, ua_.z, ua_.w), u1_ = make_uint4(ub_.x, ub_.y, ub_.z, ub_.w); \
    const float uu_[16] = {BFLO(u0_.x), BFHI(u0_.x), BFLO(u0_.y), BFHI(u0_.y), BFLO(u0_.z), BFHI(u0_.z), BFLO(u0_.w), BFHI(u0_.w), \
                           BFLO(u1_.x), BFHI(u1_.x), BFLO(u1_.y), BFHI(u1_.y), BFLO(u1_.z), BFHI(u1_.z), BFLO(u1_.w), BFHI(u1_.w)}; \
    float sra_[4] = {0.f, 0.f, 0.f, 0.f}, sia_[4] = {0.f, 0.f, 0.f, 0.f}; \
    _Pragma("unroll") for (int c_ = 0; c_ < 16; ++c_) { sra_[c_ & 3] = fmaf(uu_[c_], k.cr[c_], sra_[c_ & 3]); sia_[c_ & 3] = fmaf(uu_[c_], k.ci[c_], sia_[c_ & 3]); } \
    const float sr_ = (sra_[0] + sra_[1]) + (sra_[2] + sra_[3]), si_ = (sia_[0] + sia_[1]) + (sia_[2] + sia_[3]); \
    const float nxr_ = fmaf(k.ar, xr, fmaf(-k.ai, xi, sr_)), nxi_ = fmaf(k.ar, xi, fmaf(k.ai, xr, si_)); xr = nxr_; xi = nxi_; } while (0)

__device__ __forceinline__ void ph_ssm_local(const int tid_, const int bid_, const bf16_t* z_gen, const float* lam_re, const float* lam_im, const float* log_dt,
                                             const float* b_re, const float* b_im, float* E_gen, unsigned char* lds) {
    const GAS bf16_t* z = (const GAS bf16_t*)z_gen;
    GAS float* E = (GAS float*)E_gen;
    const unsigned ul = (unsigned)(size_t)(LAS unsigned char*)lds + (unsigned)(tid_ >> 6) * 2048u;

    const int p = tid_ & 63;
    for (int unit = bid_ * 8 + (tid_ >> 6); unit < NB * NG * NCH; unit += NBLK * 8) {
        const int c = unit % NCH, bg = unit / NCH, g = bg % NG, b = bg / NG;
        SsmCoef k; ssm_setup(k, g, p, lam_re, lam_im, log_dt, b_re, b_im);
        float xr = 0.f, xi = 0.f;
        const GAS bf16_t* zu = z + ((size_t)b * S + (size_t)c * SCH) * DIN + OFF_SU + g * 16;
        {
            const u32x4_t a0 = *(const GAS u32x4_t*)(zu + (size_t)p * DIN), a1 = *(const GAS u32x4_t*)(zu + (size_t)p * DIN + 8);
            *(LAS u32x4_t*)(ul + 32 * p) = a0; *(LAS u32x4_t*)(ul + 32 * p + 16) = a1;
            asm volatile("s_waitcnt lgkmcnt(0)" ::: "memory");
        }
#pragma unroll 8
        for (int t = 0; t < SCH; ++t) SSM_STEP((LAS unsigned char*)(ul + 32 * t));
        asm volatile("s_waitcnt lgkmcnt(0)" ::: "memory");
        GAS float* e = E + ((size_t)bg * NCH + c) * 128;
        e[p] = xr; e[64 + p] = xi;
    }
}
__device__ __forceinline__ void ph_ssm_final(const int tid_, const int bid_, const bf16_t* z_gen, const float* lam_re, const float* lam_im, const float* log_dt,
                                             const float* b_re, const float* b_im, const float* c_re, const float* c_im, const float* dsk, const float* E_gen,
                                             float* gv_gen, bf16_t* gvb_gen, unsigned char* lds) {
    const GAS bf16_t* z = (const GAS bf16_t*)z_gen;
    const GAS float* E = (const GAS float*)E_gen;
    GAS float* gv = (GAS float*)gv_gen;
    GAS bf16_t* gvb = (GAS bf16_t*)gvb_gen;

    typedef float f32x4 __attribute__((ext_vector_type(4)));
    const int p = tid_ & 63, wv = tid_ >> 6, li_ = p & 15, kq = p >> 4;
    float* Xl = (float*)(lds + wv * (16 * 132 * 4));
    const unsigned ul = (unsigned)(size_t)(LAS unsigned char*)lds + 8u * (16 * 132 * 4) + (unsigned)wv * 2048u;
    for (int unit = bid_ * 8 + wv; unit < NB * NG * NCH; unit += NBLK * 8) {
        const int c = unit % NCH, bg = unit / NCH, g = bg % NG, b = bg / NG;
        SsmCoef k; ssm_setup(k, g, p, lam_re, lam_im, log_dt, b_re, b_im);
        float cm[32];
        {
            const float* src = ((kq < 2) ? c_re : c_im) + (size_t)(g * 16 + li_) * NP + 32 * (kq & 1);
            const float sg = (kq < 2) ? 1.f : -1.f;
#pragma unroll
            for (int i = 0; i < 8; ++i) { const float4 v = *(const float4*)(src + 4 * i); cm[4 * i] = sg * v.x; cm[4 * i + 1] = sg * v.y; cm[4 * i + 2] = sg * v.z; cm[4 * i + 3] = sg * v.w; }
        }
        const float dk = dsk[g * 16 + li_];
        float xr = 0.f, xi = 0.f;
        {
            float a64r = k.ar, a64i = k.ai;
#pragma unroll
            for (int i = 0; i < 6; ++i) { const float r2 = a64r * a64r - a64i * a64i, i2 = 2.f * a64r * a64i; a64r = r2; a64i = i2; }
            const GAS float* ep = E + (size_t)bg * NCH * 128;
            for (int cc = 0; cc < c; ++cc) {
                const float er = ep[cc * 128 + p], ei = ep[cc * 128 + 64 + p];
                const float nr = a64r * xr - a64i * xi + er, ni = a64r * xi + a64i * xr + ei;
                xr = nr; xi = ni;
            }
        }
        const size_t t0 = (size_t)b * S + (size_t)c * SCH;
        const GAS bf16_t* zu = z + t0 * DIN + OFF_SU + g * 16;
        {
            const u32x4_t a0 = *(const GAS u32x4_t*)(zu + (size_t)p * DIN), a1 = *(const GAS u32x4_t*)(zu + (size_t)p * DIN + 8);
            *(LAS u32x4_t*)(ul + 32 * p) = a0; *(LAS u32x4_t*)(ul + 32 * p + 16) = a1;
            asm volatile("s_waitcnt lgkmcnt(0)" ::: "memory");
        }
        for (int sb = 0; sb < SCH / 16; ++sb) {
#pragma unroll 8
            for (int tt = 0; tt < 16; ++tt) {
                SSM_STEP((LAS unsigned char*)(ul + 32 * (sb * 16 + tt)));
                Xl[tt * 132 + p] = xr; Xl[tt * 132 + 64 + p] = xi;
            }
            asm volatile("s_waitcnt lgkmcnt(0)" ::: "memory");
            f32x4 af[8];
#pragma unroll
            for (int i = 0; i < 8; ++i) af[i] = *(const f32x4*)(Xl + li_ * 132 + 32 * kq + 4 * i);
            f32x4 acc = (f32x4){0.f, 0.f, 0.f, 0.f};
#pragma unroll
            for (int s2 = 0; s2 < 32; ++s2) acc = __builtin_amdgcn_mfma_f32_16x16x4f32(af[s2 >> 2][s2 & 3], cm[s2], acc, 0, 0, 0);
            asm volatile("s_waitcnt lgkmcnt(0)" ::: "memory");
#pragma unroll
            for (int r = 0; r < 4; ++r) {
                const size_t t = t0 + sb * 16 + 4 * kq + r;
                const float uv = __builtin_bit_cast(float, (unsigned)(*(const LAS bf16_t*)(ul + 32 * (sb * 16 + 4 * kq + r) + 2 * li_)) << 16);
                const float gl = gelu_tanh(acc[r] + dk * uv);
                gv[t * SSMD + g * 16 + li_] = gl;
                gvb[t * GLU_P + g * 16 + li_] = (bf16_t)f2bf(gl);
            }
        }
    }
}

__device__ __forceinline__ void ph_dil_combine(const int tid_, const int bid_, const float* od_gen, const float* lse_gen, bf16_t* mixb_gen) {
    const GAS float* od = (const GAS float*)od_gen;
    const GAS float* lse = (const GAS float*)lse_gen;
    GAS bf16_t* mixb = (GAS bf16_t*)mixb_gen;
    for (long i = GTID(); i < (long)T * (DILD / 8); i += GSTRIDE()) {
        const int t = (int)(i / (DILD / 8)), col = (int)(i % (DILD / 8)) * 8, head = col >> 6, g = head / 3, hg = head % 3;
        const float l0 = lse[(long)t * 9 + hg], l1 = lse[(long)t * 9 + 3 + hg], l2 = lse[(long)t * 9 + 6 + hg];
        const float m = fmaxf(l0, fmaxf(l1, l2));
        const float e0 = expf(l0 - m), e1 = expf(l1 - m), e2 = expf(l2 - m);
        const float eg = (g == 0) ? e0 : (g == 1 ? e1 : e2);
        const float w = eg / (e0 + e1 + e2);
        const float4 v0 = ldgf4((const GAS void*)(od + (long)t * DILD + col)), v1 = ldgf4((const GAS void*)(od + (long)t * DILD + col + 4));
        stg16((GAS void*)(mixb + (long)t * D + 896 + col), make_uint4(pk2(v0.x * w, v0.y * w), pk2(v0.z * w, v0.w * w), pk2(v1.x * w, v1.y * w), pk2(v1.z * w, v1.w * w)));
    }
}


constexpr int DK_ROW = 72, DV_ROW = 68;
constexpr int DK_BYTES = 64 * DK_ROW * 2, DV_BYTES = 64 * DV_ROW * 2;
__device__ __forceinline__ void ph_dil_attn_mfma(const int tid_, const int bid_, const bf16_t* zb_gen, float* od_gen, float* lse_gen, unsigned char* lds) {
    const GAS bf16_t* zb = (const GAS bf16_t*)zb_gen;
    GAS float* od = (GAS float*)od_gen;
    GAS float* lse = (GAS float*)lse_gen;

    typedef short bf16x8 __attribute__((ext_vector_type(8)));
    typedef float f32x4 __attribute__((ext_vector_type(4)));
    const int lane = tid_ & 63, wv = tid_ >> 6, li = lane & 15, lq = lane >> 4;
    const int skey = tid_ >> 3, spart = tid_ & 7;
    for (int idx = bid_; idx < 576; idx += NBLK) {
        const int u = idx & 15, bh = idx >> 4, b = bh / 9, head = bh % 9, g = head / 3;
        const int dil = (g == 0) ? 1 : (g == 1 ? 4 : 16);
        const int i_q = (g == 0) ? u : (g == 1 ? (u & 3) : 0), m_res = (g == 0) ? 0 : (g == 1 ? (u >> 2) : u);
        const int q0 = i_q * 128, qw = q0 + wv * 16;
        const size_t tb = (size_t)b * S + m_res;
        bf16x8 qf[2];
#pragma unroll
        for (int ks = 0; ks < 2; ++ks) qf[ks] = *(const GAS bf16x8*)(zb + (tb + (size_t)(qw + li) * dil) * DIN + OFF_DQ + head * 64 + 32 * ks + 8 * lq);
        f32x4 o[4];
#pragma unroll
        for (int dt = 0; dt < 4; ++dt) o[dt] = (f32x4){0.f, 0.f, 0.f, 0.f};
        float mrun = -1e30f, lrun = 0.f;
        const int kb_lo = (i_q == 0) ? 0 : (2 * i_q - 2), kb_hi = 2 * i_q + 2;
        uint4 rk, rv;
        {
            const size_t tk = tb + (size_t)(kb_lo * 64 + skey) * dil;
            rk = ldg16((const GAS void*)(zb + tk * DIN + OFF_DK + head * 64 + 8 * spart));
            rv = ldg16((const GAS void*)(zb + tk * DIN + OFF_DV + head * 64 + 8 * spart));
        }
        __syncthreads();
        {
            *(uint4*)(lds + (skey * DK_ROW + 8 * spart) * 2) = rk;
            bf16_t* vt = (bf16_t*)(lds + 2 * DK_BYTES);
            const unsigned w[4] = {rv.x, rv.y, rv.z, rv.w};
#pragma unroll
            for (int e = 0; e < 8; ++e) vt[(8 * spart + e) * DV_ROW + skey] = (bf16_t)((w[e >> 1] >> ((e & 1) * 16)) & 0xffffu);
        }
        __syncthreads();
        for (int kb = kb_lo; kb < kb_hi; ++kb) {
            const int k0 = kb * 64, par = (kb - kb_lo) & 1;
            const bool has_next = (kb + 1 < kb_hi);
            if (has_next) {
                const size_t tk = tb + (size_t)(k0 + 64 + skey) * dil;
                rk = ldg16((const GAS void*)(zb + tk * DIN + OFF_DK + head * 64 + 8 * spart));
                rv = ldg16((const GAS void*)(zb + tk * DIN + OFF_DV + head * 64 + 8 * spart));
            }
            if (k0 <= qw + 15 && k0 + 63 >= qw - 128) {
                const unsigned char* kt = lds + par * DK_BYTES;
                const unsigned char* vt = lds + 2 * DK_BYTES + par * DV_BYTES;
                bf16x8 kf[4][2], vf[4][2];
#pragma unroll
                for (int ti = 0; ti < 4; ++ti)
#pragma unroll
                    for (int ks = 0; ks < 2; ++ks) kf[ti][ks] = *(const bf16x8*)(kt + ((16 * ti + li) * DK_ROW + 32 * ks + 8 * lq) * 2);
#pragma unroll
                for (int dt = 0; dt < 4; ++dt)
#pragma unroll
                    for (int s2 = 0; s2 < 2; ++s2) {
                        const unsigned char* vp = vt + ((16 * dt + li) * DV_ROW + 32 * s2 + 4 * lq) * 2;
                        const uint2 lo = *(const uint2*)vp, hi = *(const uint2*)(vp + 32);
                        const uint4 w = make_uint4(lo.x, lo.y, hi.x, hi.y);
                        vf[dt][s2] = __builtin_bit_cast(bf16x8, w);
                    }
                __builtin_amdgcn_sched_barrier(0);
                f32x4 sc[4];
#pragma unroll
                for (int ti = 0; ti < 4; ++ti) {
                    sc[ti] = (f32x4){0.f, 0.f, 0.f, 0.f};
#pragma unroll
                    for (int ks = 0; ks < 2; ++ks) sc[ti] = __builtin_amdgcn_mfma_f32_16x16x32_bf16(kf[ti][ks], qf[ks], sc[ti], 0, 0, 0);
                }
                if (k0 + 63 > qw || k0 < qw + 15 - 128) {
                    const int qpos = qw + li;
#pragma unroll
                    for (int ti = 0; ti < 4; ++ti)
#pragma unroll
                        for (int e = 0; e < 4; ++e) { const int key = k0 + 16 * ti + 4 * lq + e; if (key > qpos || key < qpos - 128) sc[ti][e] = -1e30f; }
                }
                float mx = -1e30f;
#pragma unroll
                for (int ti = 0; ti < 4; ++ti)
#pragma unroll
                    for (int e = 0; e < 4; ++e) mx = fmaxf(mx, sc[ti][e]);
                mx = fmaxf(mx, shflx(mx, 16, lane)); mx = fmaxf(mx, shflx(mx, 32, lane));
                const float mnew = fmaxf(mrun, mx);
                const float alpha = __builtin_amdgcn_exp2f(mrun - mnew);
                float rs = 0.f;
#pragma unroll
                for (int ti = 0; ti < 4; ++ti)
#pragma unroll
                    for (int e = 0; e < 4; ++e) { const float p = (sc[ti][e] > -1e29f) ? __builtin_amdgcn_exp2f(sc[ti][e] - mnew) : 0.f; sc[ti][e] = p; rs += p; }
                rs += shflx(rs, 16, lane); rs += shflx(rs, 32, lane);
                lrun = lrun * alpha + rs; mrun = mnew;
#pragma unroll
                for (int dt = 0; dt < 4; ++dt) o[dt] = o[dt] * alpha;
                bf16x8 pb[2];
#pragma unroll
                for (int s2 = 0; s2 < 2; ++s2) {
                    const uint4 w = make_uint4(pk2(sc[2 * s2][0], sc[2 * s2][1]), pk2(sc[2 * s2][2], sc[2 * s2][3]), pk2(sc[2 * s2 + 1][0], sc[2 * s2 + 1][1]), pk2(sc[2 * s2 + 1][2], sc[2 * s2 + 1][3]));
                    pb[s2] = __builtin_bit_cast(bf16x8, w);
                }
#pragma unroll
                for (int dt = 0; dt < 4; ++dt)
#pragma unroll
                    for (int s2 = 0; s2 < 2; ++s2) o[dt] = __builtin_amdgcn_mfma_f32_16x16x32_bf16(vf[dt][s2], pb[s2], o[dt], 0, 0, 0);
            }
            if (has_next) {
                *(uint4*)(lds + (par ^ 1) * DK_BYTES + (skey * DK_ROW + 8 * spart) * 2) = rk;
                bf16_t* vtw = (bf16_t*)(lds + 2 * DK_BYTES + (par ^ 1) * DV_BYTES);
                const unsigned w[4] = {rv.x, rv.y, rv.z, rv.w};
#pragma unroll
                for (int e = 0; e < 8; ++e) vtw[(8 * spart + e) * DV_ROW + skey] = (bf16_t)((w[e >> 1] >> ((e & 1) * 16)) & 0xffffu);
            }
            __syncthreads();
        }
        const float inv = 1.f / lrun;
        const size_t tq = tb + (size_t)(qw + li) * dil;
        GAS float* op = od + tq * DILD + head * 64 + 4 * lq;
#pragma unroll
        for (int dt = 0; dt < 4; ++dt) *(GAS f32x4*)(op + 16 * dt) = o[dt] * inv;
        if (lq == 0) lse[tq * 9 + head] = (mrun + __builtin_amdgcn_logf(lrun)) * 0.6931471805599453f;
    }
}


constexpr int RCOLS = 80;
__device__ __forceinline__ void ph_router_mfma(const int tid_, const int bid_, const float* h_gen, const float* W2_gen, const float* bg, const float* br,
                                               int* eidx, float* gate, float* rsbuf, int* cnt, unsigned char* lds) {
    const GAS float* h = (const GAS float*)h_gen;

    typedef float f32x4 __attribute__((ext_vector_type(4)));
    const int lane = tid_ & 63, wv = tid_ >> 6, li = lane & 15, lq = lane >> 4, kq8 = wv;
    float* part = (float*)lds;
    float* ssp = (float*)(lds + 8 * 32 * RCOLS * 4);
    const int t0 = bid_ * 32;
    typedef short bf16x8 __attribute__((ext_vector_type(8)));
    const GAS float* hp = h + (size_t)(t0 + li) * D + 256 * kq8 + 8 * lq;
    const GAS bf16_t* wp = (const GAS bf16_t*)W2_gen + (size_t)kq8 * 8 * 5 * 2 * 64 * 8 + lane * 8;
    f32x4 acc[2][5];
#pragma unroll
    for (int tt = 0; tt < 2; ++tt)
#pragma unroll
        for (int nb = 0; nb < 5; ++nb) acc[tt][nb] = (f32x4){0.f, 0.f, 0.f, 0.f};
    float ss[2] = {0.f, 0.f};
#pragma unroll 2
    for (int s = 0; s < 8; ++s) {
        f32x4 a0[2], a1[2];
#pragma unroll
        for (int tt = 0; tt < 2; ++tt) { a0[tt] = *(const GAS f32x4*)(hp + (size_t)(16 * tt) * D + 32 * s); a1[tt] = *(const GAS f32x4*)(hp + (size_t)(16 * tt) * D + 32 * s + 4); }
        bf16x8 bw[5][2];
#pragma unroll
        for (int nb = 0; nb < 5; ++nb)
#pragma unroll
            for (int hl = 0; hl < 2; ++hl) bw[nb][hl] = *(const GAS bf16x8*)(wp + (size_t)((s * 5 + nb) * 2 + hl) * 512);
#pragma unroll
        for (int tt = 0; tt < 2; ++tt) {
            const float av[8] = {a0[tt][0], a0[tt][1], a0[tt][2], a0[tt][3], a1[tt][0], a1[tt][1], a1[tt][2], a1[tt][3]};
            unsigned hi[4], lo[4];
#pragma unroll
            for (int e = 0; e < 4; ++e) {
                const float x0 = av[2 * e], x1 = av[2 * e + 1];
                ss[tt] += x0 * x0 + x1 * x1;
                const unsigned h0 = f2bf(x0), h1 = f2bf(x1);
                hi[e] = h0 | (h1 << 16);
                lo[e] = pk2(x0 - __builtin_bit_cast(float, h0 << 16), x1 - __builtin_bit_cast(float, h1 << 16));
            }
            const uint4 hw = make_uint4(hi[0], hi[1], hi[2], hi[3]), lw = make_uint4(lo[0], lo[1], lo[2], lo[3]);
            const bf16x8 ah = __builtin_bit_cast(bf16x8, hw), al = __builtin_bit_cast(bf16x8, lw);
#pragma unroll
            for (int nb = 0; nb < 5; ++nb) {
                acc[tt][nb] = __builtin_amdgcn_mfma_f32_16x16x32_bf16(ah, bw[nb][0], acc[tt][nb], 0, 0, 0);
                acc[tt][nb] = __builtin_amdgcn_mfma_f32_16x16x32_bf16(al, bw[nb][0], acc[tt][nb], 0, 0, 0);
                acc[tt][nb] = __builtin_amdgcn_mfma_f32_16x16x32_bf16(ah, bw[nb][1], acc[tt][nb], 0, 0, 0);
            }
        }
    }
#pragma unroll
    for (int tt = 0; tt < 2; ++tt) {
        float sv = ss[tt];
        sv += shflx(sv, 16, lane); sv += shflx(sv, 32, lane);
        if (lq == 0) ssp[kq8 * 32 + 16 * tt + li] = sv;
#pragma unroll
        for (int nb = 0; nb < 5; ++nb)
#pragma unroll
            for (int r = 0; r < 4; ++r) part[(kq8 * 32 + 16 * tt + 4 * lq + r) * RCOLS + 16 * nb + li] = acc[tt][nb][r];
    }
    __syncthreads();
    float* lgs = (float*)(lds + 8 * 32 * RCOLS * 4 + 1024);
    for (int i = tid_; i < 32 * RCOLS; i += NTHR) {
        const int tk32 = i / RCOLS, c = i % RCOLS;
        float sst = 0.f, v = 0.f;
#pragma unroll
        for (int kq = 0; kq < 8; ++kq) { sst += ssp[kq * 32 + tk32]; v += part[(kq * 32 + tk32) * RCOLS + c]; }
        const float rs = 1.0f / sqrtf(sst / (float)D + EPS);
        float bias = 0.f;
        if (c < 64) bias = br[c]; else if (c < 72) bias = bg[c - 64];
        lgs[i] = v * rs + bias;
        if (c == 0) rsbuf[bid_ * 32 + tk32] = rs;
    }
    __syncthreads();
    if (tid_ < 32) {
        const int t = bid_ * 32 + tid_;
        const float* lg = lgs + tid_ * RCOLS;
        int gi = 0; float mx = lg[64];
        for (int i = 1; i < 8; ++i) { const float v = lg[64 + i]; if (v > mx) { mx = v; gi = i; } }
        float sum = 0.f;
        for (int i = 0; i < 8; ++i) sum += expf(lg[64 + i] - mx);
        const float gp = 1.f / sum;
        const float* e8 = lg + gi * 8;
        int i1 = 0; float v1 = e8[0];
        for (int i = 1; i < 8; ++i) { const float v = e8[i]; if (v > v1) { v1 = v; i1 = i; } }
        int i2 = 0; float v2 = -INFINITY;
        for (int i = 0; i < 8; ++i) { const float v = e8[i]; if (i != i1 && v > v2) { v2 = v; i2 = i; } }
        const float e2 = expf(v2 - v1);
        const float a1 = 1.f / (1.f + e2), a2 = e2 / (1.f + e2);
        eidx[t * 2] = gi * 8 + i1; eidx[t * 2 + 1] = gi * 8 + i2;
        gate[t * 2] = a1 * gp; gate[t * 2 + 1] = a2 * gp;
        atomicAdd(&cnt[gi * 8 + i1], 1); atomicAdd(&cnt[gi * 8 + i2], 1);
    }
    __syncthreads();
}
__device__ __forceinline__ void ph_moe_scatter(const int tid_, const int bid_, const int* eidx, const float* gate, const int* cnt, int* cursor,
                                               const float* h, const float* rsbuf, const float* gn, bf16_t* Ag, float* slot_gate, int* tok_slot, int* ps, int* lte) {
    if (tid_ == 0) {
        int acc = 0;
        for (int e = 0; e < NE; ++e) { ps[e] = acc; acc += ((cnt[e] + MT - 1) / MT) * MT; }
        ps[NE] = acc;
    }
    __syncthreads();
    for (int i = tid_; i < NTILE; i += NTHR) {
        const int r = i * MT; int e = 0;
        if (r < ps[NE]) { for (int k = 0; k < NE; ++k) if (r >= ps[k] && r < ps[k + 1]) e = k; }
        lte[i] = e;
    }
    if (tid_ == 0) lte[NTILE] = ps[NE] / MT;
    const int lane = tid_ & 63, wv = tid_ >> 6, gw = bid_ * 8 + wv;
    int myslot = 0;
    if (lane < 8) { const int a = gw + NBLK * 8 * lane; const int e = eidx[a]; myslot = ps[e] + atomicAdd(&cursor[e], 1); tok_slot[a] = myslot; slot_gate[myslot] = gate[a]; }
    float4 gq0[4], gq1[4];
#pragma unroll
    for (int jj = 0; jj < 4; ++jj) { const int c = jj * 512 + lane * 8; gq0[jj] = ldgf4((const GAS void*)((const GAS float*)gn + c)); gq1[jj] = ldgf4((const GAS void*)((const GAS float*)gn + c + 4)); }
#pragma unroll 2
    for (int j = 0; j < 8; ++j) {
        const int a = gw + NBLK * 8 * j;
        const int slot = __builtin_amdgcn_readlane(myslot, j);
        const int tok = a >> 1;
        const float rs = rsbuf[tok];
        const GAS float* src = (const GAS float*)h + (size_t)tok * D;
        GAS bf16_t* dst = (GAS bf16_t*)Ag + (size_t)slot * D;
#pragma unroll
        for (int jj = 0; jj < 4; ++jj) {
            const int c = jj * 512 + lane * 8;
            const float4 v0 = ldgf4((const GAS void*)(src + c)), v1 = ldgf4((const GAS void*)(src + c + 4));
            const float4 g0 = gq0[jj], g1 = gq1[jj];
            stg16((GAS void*)(dst + c), make_uint4(pk2(v0.x * rs * g0.x, v0.y * rs * g0.y), pk2(v0.z * rs * g0.z, v0.w * rs * g0.w),
                                                   pk2(v1.x * rs * g1.x, v1.y * rs * g1.y), pk2(v1.z * rs * g1.z, v1.w * rs * g1.w)));
        }
    }
}
__device__ __forceinline__ void ph_moe_combine_norm(const int tid_, const int bid_, float* h_gen, const bf16_t* Yb_gen, const int* tok_slot, const float* g_gen, bf16_t* hnb_gen) {
    GAS float* h = (GAS float*)h_gen; const GAS bf16_t* Yb = (const GAS bf16_t*)Yb_gen; const GAS float* g = (const GAS float*)g_gen; GAS bf16_t* hnb = (GAS bf16_t*)hnb_gen;
    const int lane = tid_ & 63, wv = tid_ >> 6;
    int myslots = 0;
    if (lane < 8) myslots = tok_slot[(bid_ * 8 + wv + NBLK * 8 * (lane >> 1)) * 2 + (lane & 1)];
    float4 gq[8];
#pragma unroll
    for (int j = 0; j < 8; ++j) gq[j] = ldgf4((const GAS void*)(g + (lane + 64 * j) * 4));
#pragma unroll 4
    for (int j = 0; j < 4; ++j) {
        const int t = bid_ * 8 + wv + NBLK * 8 * j;
        const int s0 = __builtin_amdgcn_readlane(myslots, 2 * j), s1 = __builtin_amdgcn_readlane(myslots, 2 * j + 1);
        float4 hv[8]; float ss = 0.f;
#pragma unroll
        for (int j = 0; j < 8; ++j) {
            const int c = (lane + 64 * j) * 4;
            hv[j] = ldgf4((const GAS void*)(h + (size_t)t * D + c));
            const uint2 a = ldg8((const GAS void*)(Yb + (size_t)s0 * D + c)), b = ldg8((const GAS void*)(Yb + (size_t)s1 * D + c));
            hv[j].x += __builtin_bit_cast(float, a.x << 16) + __builtin_bit_cast(float, b.x << 16);
            hv[j].y += __builtin_bit_cast(float, a.x & 0xffff0000u) + __builtin_bit_cast(float, b.x & 0xffff0000u);
            hv[j].z += __builtin_bit_cast(float, a.y << 16) + __builtin_bit_cast(float, b.y << 16);
            hv[j].w += __builtin_bit_cast(float, a.y & 0xffff0000u) + __builtin_bit_cast(float, b.y & 0xffff0000u);
            ss += hv[j].x * hv[j].x + hv[j].y * hv[j].y + hv[j].z * hv[j].z + hv[j].w * hv[j].w;
            { f32x4_t w_; w_.x = hv[j].x; w_.y = hv[j].y; w_.z = hv[j].z; w_.w = hv[j].w; *(GAS f32x4_t*)(h + (size_t)t * D + c) = w_; }
        }
#pragma unroll
        for (int o = 32; o > 0; o >>= 1) ss += shflx(ss, o, lane);
        const float rs = 1.0f / sqrtf(ss * (1.0f / (float)D) + EPS);
#pragma unroll
        for (int j = 0; j < 8; ++j) {
            const int c = (lane + 64 * j) * 4;
            const float4 gv = gq[j];
            stg8((GAS void*)(hnb + (size_t)t * D + c), make_uint2(pk2(hv[j].x * rs * gv.x, hv[j].y * rs * gv.y), pk2(hv[j].z * rs * gv.z, hv[j].w * rs * gv.w)));
        }
    }
}
__device__ __forceinline__ void ph_init_rows(const int tid_, const int bid_, const float* x, const float* g, float* h, bf16_t* hb, ssq_t* ss) {
    const int lane = tid_ & 63, wv = tid_ >> 6;
    for (int t = bid_ * 8 + wv; t < T; t += NBLK * 8) {
        float sq = 0.f;
#pragma unroll
        for (int j = 0; j < 8; ++j) {
            const int c = (lane + 64 * j) * 4;
            const float4 v = *(const float4*)(x + (size_t)t * D + c);
            const float4 gv = *(const float4*)(g + c);
            *(float4*)(h + (size_t)t * D + c) = v;
            *(uint2*)(hb + (size_t)t * D + c) = make_uint2(pk2(v.x * gv.x, v.y * gv.y), pk2(v.z * gv.z, v.w * gv.w));
            sq += v.x * v.x + v.y * v.y + v.z * v.z + v.w * v.w;
        }
#pragma unroll
        for (int o = 32; o > 0; o >>= 1) sq += shflx(sq, o, lane);
        if (lane == 0) ss[t] = ss_enc(sq);
    }
}
__device__ __forceinline__ void ph_final_norm(const int tid_, const int bid_, const float* h, const ssq_t* ss, const float* g, float* out) {
    for (long i = GTID(); i < (long)T * D / 4; i += GSTRIDE()) {
        const int t = (int)(i / (D / 4)), c = (int)(i % (D / 4)) * 4;
        const float rs = 1.0f / sqrtf(ss_dec(ss[t]) * (1.0f / (float)D) + EPS);
        const float4 v = ((const float4*)h)[i]; const float4 gv = *(const float4*)(g + c);
        ((float4*)out)[i] = make_float4(v.x * rs * gv.x, v.y * rs * gv.y, v.z * rs * gv.z, v.w * rs * gv.w);
    }
}

#define EPI_DECODE() unsigned ez_ = 0u; asm volatile("" : "+s"(ez_)); int ew_ = wave_s; asm volatile("" : "+s"(ew_)); \
    const int el_ = (int)__builtin_amdgcn_mbcnt_hi(~0u, __builtin_amdgcn_mbcnt_lo(~0u, ez_)); \
    const int wr = ew_ >> 2, wc = ew_ & 3, fr = el_ & 15, fq = el_ >> 4;

struct EpiPle {
    static constexpr bool PERM = false, AFTER_DRAIN = false;
    float* H; const bf16_t* aux; const float* gnext; bf16_t* hb; ssq_t* ssn; int wave_s;
    __device__ __forceinline__ void operator()(const pg8::f32x4 (&acc)[2][2][4][2], const pg8::Unit& u, int, int, int, int) const {
        EPI_DECODE();
        const int row0 = u.pm * 256 + wr * 64 + fr, col0 = u.pn * 256 + wc * 32 + fq * 4;
        pg8::f32x4 gnv[2][2];
#pragma unroll
        for (int bj = 0; bj < 2; ++bj)
#pragma unroll
            for (int n = 0; n < 2; ++n) gnv[bj][n] = *(const GAS pg8::f32x4*)(gnext + col0 + bj * 128 + n * 16);
#pragma unroll
        for (int ai = 0; ai < 2; ++ai)
#pragma unroll
            for (int m = 0; m < 4; ++m) {
                const size_t row = (size_t)(row0 + ai * 128 + m * 16);
                float sq = 0.f;
#pragma unroll
                for (int bj = 0; bj < 2; ++bj)
#pragma unroll
                    for (int n = 0; n < 2; ++n) {
                        const int col = col0 + bj * 128 + n * 16;
                        const pg8::f32x4 v = acc[ai][bj][m][n];
                        GAS pg8::f32x4* p = (GAS pg8::f32x4*)(H + row * D + col);
                        const uint2 ab = ldg8((const GAS void*)(aux + row * D + col));
                        const float a[4] = {__uint_as_float(ab.x << 16), __uint_as_float(ab.x & 0xffff0000u), __uint_as_float(ab.y << 16), __uint_as_float(ab.y & 0xffff0000u)};
                        const pg8::f32x4 gn = gnv[bj][n];
                        pg8::f32x4 o = *p;
#pragma unroll
                        for (int e = 0; e < 4; ++e) { o[e] += a[e] * (1.f / (1.f + __expf(-v[e]))); sq += o[e] * o[e]; }
                        *p = o;
                        stg8((GAS void*)(hb + row * D + col), make_uint2(pk2(o[0] * gn[0], o[1] * gn[1]), pk2(o[2] * gn[2], o[3] * gn[3])));
                    }
                sq += shflx(sq, 16, el_); sq += shflx(sq, 32, el_);
                if (fq == 0) (void)__hip_atomic_fetch_add((GAS ssq_t*)ssn + row, ss_enc(sq), __ATOMIC_RELAXED, __HIP_MEMORY_SCOPE_AGENT);
            }
    }
};


struct EpiZ {
    static constexpr bool PERM = true, AFTER_DRAIN = false;
    bf16_t* Z; int ldz; int nvalid; const ssq_t* ss; int wave_s;
    __device__ __forceinline__ void operator()(const pg8::f32x4 (&acc)[2][2][4][2], const pg8::Unit& u, int, int, int, int) const {
        EPI_DECODE();
        const int row0 = u.pm * 256 + wr * 64 + fr, col0 = u.pn * 256 + wc * 32 + 8 * fq;
#pragma unroll
        for (int ai = 0; ai < 2; ++ai)
#pragma unroll
            for (int m = 0; m < 4; ++m) {
                const size_t row = (size_t)(row0 + ai * 128 + m * 16);
                const float rs = 1.0f / sqrtf(ss_dec(((const GAS ssq_t*)ss)[row]) * (1.0f / (float)D) + EPS);
#pragma unroll
                for (int bj = 0; bj < 2; ++bj) {
                    const int col = col0 + bj * 128;
                    if (col < nvalid) {
                        const pg8::f32x4 v0 = acc[ai][bj][m][0] * rs, v1 = acc[ai][bj][m][1] * rs;
                        stg16((GAS void*)(Z + row * ldz + col), make_uint4(pk2(v0[0], v0[1]), pk2(v0[2], v0[3]), pk2(v1[0], v1[1]), pk2(v1[2], v1[3])));
                    }
                }
            }
    }
};
struct EpiB16S {
    static constexpr bool PERM = true, AFTER_DRAIN = false;
    bf16_t* O; int ldo; int nvalid; const float* rsrow; const float* rscol; float cs; int wave_s;
    __device__ __forceinline__ void operator()(const pg8::f32x4 (&acc)[2][2][4][2], const pg8::Unit& u, int, int, int, int) const {
        EPI_DECODE();
        const int row0 = u.pm * 256 + wr * 64 + fr, col0 = u.pn * 256 + wc * 32 + 8 * fq;
#pragma unroll
        for (int bj = 0; bj < 2; ++bj) {
            const int col = col0 + bj * 128;
            if (col < nvalid) {
                pg8::f32x4 c0 = (pg8::f32x4){cs, cs, cs, cs}, c1 = c0;
                if (rscol) { c0 = c0 * *(const GAS pg8::f32x4*)(rscol + col); c1 = c1 * *(const GAS pg8::f32x4*)(rscol + col + 4); }
#pragma unroll
                for (int ai = 0; ai < 2; ++ai)
#pragma unroll
                    for (int m = 0; m < 4; ++m) {
                        const size_t row = (size_t)(row0 + ai * 128 + m * 16);
                        const float rr = rsrow ? ((const GAS float*)rsrow)[row] : 1.f;
                        const pg8::f32x4 v0 = acc[ai][bj][m][0] * c0 * rr, v1 = acc[ai][bj][m][1] * c1 * rr;
                        stg16((GAS void*)(O + row * ldo + col), make_uint4(pk2(v0[0], v0[1]), pk2(v0[2], v0[3]), pk2(v1[0], v1[1]), pk2(v1[2], v1[3])));
                    }
            }
        }
    }
};

__device__ __forceinline__ void unpack8(const uint4 w, float (&f)[8]) {
    f[0] = BFLO(w.x); f[1] = BFHI(w.x); f[2] = BFLO(w.y); f[3] = BFHI(w.y); f[4] = BFLO(w.z); f[5] = BFHI(w.z); f[6] = BFLO(w.w); f[7] = BFHI(w.w);
}
__device__ __forceinline__ uint4 pack8(const float (&f)[8]) { return make_uint4(pk2(f[0], f[1]), pk2(f[2], f[3]), pk2(f[4], f[5]), pk2(f[6], f[7])); }
__device__ __forceinline__ void ph_light(const int tid_, const int bid_, bf16_t* zb_gen, const float* cw_gen, const float* cd_gen, const float* sd_gen, const float* cm_gen, const float* sm_gen,
                                         bf16_t* mixb_gen, float* rsq, float* rskv) {
    GAS bf16_t* zb = (GAS bf16_t*)zb_gen; GAS bf16_t* mixb = (GAS bf16_t*)mixb_gen;
    const GAS float* cw = (const GAS float*)cw_gen; const GAS float* cd = (const GAS float*)cd_gen; const GAS float* sd = (const GAS float*)sd_gen;
    const GAS float* cm = (const GAS float*)cm_gen; const GAS float* sm = (const GAS float*)sm_gen;
    const float QS = 0.125f * 1.4426950408889634f;
    const int lane = tid_ & 63, wv = tid_ >> 6;
    for (int t = bid_ * 8 + wv; t < T; t += NBLK * 8) {
        GAS bf16_t* zr = zb + (size_t)t * DIN;
        const int spos = t % S;
        if (lane < 56) {
            const int c = lane * 8;
            float cb[8], a0[8], b0[8], y[8], w0[8], w1[8], w2[8];
            unpack8(ldg16((const GAS void*)(zr + OFF_CB + c)), cb); unpack8(ldg16((const GAS void*)(zr + OFF_CC + c)), a0); unpack8(ldg16((const GAS void*)(zr + OFF_CH + c)), b0);
#pragma unroll
            for (int e = 0; e < 8; ++e) { w0[e] = cw[c + e]; w1[e] = cw[CONVD + c + e]; w2[e] = cw[2 * CONVD + c + e]; y[e] = w2[e] * a0[e] * b0[e]; }
            if (spos >= 1) { float a1[8], b1[8]; unpack8(ldg16((const GAS void*)(zr - DIN + OFF_CC + c)), a1); unpack8(ldg16((const GAS void*)(zr - DIN + OFF_CH + c)), b1);
#pragma unroll
                for (int e = 0; e < 8; ++e) y[e] += w1[e] * a1[e] * b1[e]; }
            if (spos >= 2) { float a2[8], b2[8]; unpack8(ldg16((const GAS void*)(zr - 2 * DIN + OFF_CC + c)), a2); unpack8(ldg16((const GAS void*)(zr - 2 * DIN + OFF_CH + c)), b2);
#pragma unroll
                for (int e = 0; e < 8; ++e) y[e] += w0[e] * a2[e] * b2[e]; }
#pragma unroll
            for (int e = 0; e < 8; ++e) y[e] *= cb[e];
            stg16((GAS void*)(mixb + (size_t)t * D + c), pack8(y));
        }
        if (lane < 18) {
            const int isk = lane / 9, head = lane % 9;
            GAS bf16_t* p = zr + (isk ? OFF_DK : OFF_DQ) + head * 64;
            float x1[8], x2[8], o1[8], o2[8];
            unpack8(ldg16((const GAS void*)p), x1); unpack8(ldg16((const GAS void*)(p + 8)), x2);
            const float sc = isk ? 1.f : QS;
#pragma unroll
            for (int e = 0; e < 8; ++e) { const float c = cd[t * 8 + e], sn = sd[t * 8 + e]; o1[e] = (x1[e] * c - x2[e] * sn) * sc; o2[e] = (x2[e] * c + x1[e] * sn) * sc; }
            stg16((GAS void*)p, pack8(o1)); stg16((GAS void*)(p + 8), pack8(o2));
        }
        if (lane < 54) {
            const int head = lane / 6, ch = 2 + lane % 6;
            GAS bf16_t* p = zr + OFF_DQ + head * 64 + ch * 8;
            float x[8]; unpack8(ldg16((const GAS void*)p), x);
#pragma unroll
            for (int e = 0; e < 8; ++e) x[e] *= QS;
            stg16((GAS void*)p, pack8(x));
        }
        if (lane < 2) {
            GAS bf16_t* p = zr + OFF_KR + 8 * lane;
            float x1[8], x2[8], o1[8], o2[8];
            unpack8(ldg16((const GAS void*)p), x1); unpack8(ldg16((const GAS void*)(p + 16)), x2);
#pragma unroll
            for (int e = 0; e < 8; ++e) { const float c = cm[t * 16 + 8 * lane + e], sn = sm[t * 16 + 8 * lane + e]; o1[e] = x1[e] * c - x2[e] * sn; o2[e] = x2[e] * c + x1[e] * sn; }
            stg16((GAS void*)p, pack8(o1)); stg16((GAS void*)(p + 16), pack8(o2));
        }
        float sq = 0.f, sk = 0.f;
        if (lane < 48) { float x[8]; unpack8(ldg16((const GAS void*)(zr + OFF_CQ + 8 * lane)), x);
#pragma unroll
            for (int e = 0; e < 8; ++e) sq += x[e] * x[e]; }
        if (lane < 32) { float x[8]; unpack8(ldg16((const GAS void*)(zr + OFF_CKV + 8 * lane)), x);
#pragma unroll
            for (int e = 0; e < 8; ++e) sk += x[e] * x[e]; }
#pragma unroll
        for (int o = 32; o > 0; o >>= 1) { sq += shflx(sq, o, lane); sk += shflx(sk, o, lane); }
        if (lane == 0) { rsq[t] = 1.0f / sqrtf(sq * (1.0f / (float)QR) + EPS); rskv[t] = 1.0f / sqrtf(sk * (1.0f / (float)KVR) + EPS); }
    }
}


constexpr int MG_A_BYTES = MT * 128, MG_B_BYTES = 128 * 128;
constexpr int MG_MF = MT / 64;
template <int MODE>
__device__ __forceinline__ void moe_gemm(const int tid_in, const int bid_, const LAS int* lte, const bf16_t* A, const int, const int,
                                         const float* W0, const float* W1, bf16_t* out, const float* slot_gate, PG8_LAS unsigned char* lds) {
    using namespace pg8;
    typedef unsigned u32x2_ __attribute__((ext_vector_type(2)));
    typedef float f32x2_ __attribute__((ext_vector_type(2)));
    constexpr int NPN = (MODE == 1) ? 8 : 16;
    constexpr int LDW = (MODE == 1) ? FF : D;
    constexpr int lda = (MODE == 1) ? D : FF, K = lda;
    const int tid = tid_in, wid = __builtin_amdgcn_readfirstlane(tid >> 6), lane = tid & 63, wr = wid >> 1, wc = wid & 1, fr = lane & 15, fq = lane >> 4;
    const int ntl = lte[NTILE], nt = K / 64;
    const int arow = tid >> 3, akc = tid & 7;
    const int aoff_w = arow * 128 + ((akc ^ (arow & 7)) << 4);
    const int np = lane;
    const int boff_w0 = (2 * np) * 128 + ((wid ^ ((2 * np) & 7)) << 4), boff_w1 = (2 * np + 1) * 128 + ((wid ^ ((2 * np + 1) & 7)) << 4);
    const int sw0 = ((fq) ^ (fr & 7)) << 4, sw1 = ((4 + fq) ^ (fr & 7)) << 4;
    const int aoff_r = (80 * wr + fr) * 128;
    const int boff_r = (MODE == 1) ? (32 * wc + fr) * 128 : (64 * wc + fr) * 128;
    PG8_LAS unsigned char* ldsB = lds + 2 * MG_A_BYTES;
    const int nunits_p = ((ntl + 7) >> 3) * 8 * NPN;
    for (int q = bid_; q < nunits_p; q += NBLK) {
        const int grp = q / (8 * NPN), rr = q % (8 * NPN), pl = rr >> 3, mt = grp * 8 + (rr & 7);
        if (mt >= ntl) continue;
        const int e = lte[mt];
        const int koff = (mt * 5) & (nt - 1);
        int zq = 0; asm volatile("" : "+v"(zq));
        const bf16_t* Aq = A; const float* W0q = W0; const float* W1q = W1; asm volatile("" : "+s"(Aq), "+s"(W0q), "+s"(W1q));
        const GAS bf16_t* asrc = (const GAS bf16_t*)(Aq + (size_t)(unsigned)(mt * MT + arow + zq) * lda + 8 * akc);
        const GAS float* wsrc;
        if (MODE == 1) wsrc = (const GAS float*)(((np >= 32) ? W1q : W0q) + (size_t)e * D * FF + 64 * pl + 2 * (np & 31) + zq + (size_t)(8 * wid) * LDW);
        else wsrc = (const GAS float*)(W0q + (size_t)e * FF * D + 128 * pl + 2 * np + zq + (size_t)(8 * wid) * LDW);
        f32x4 acc[MG_MF][4];
#pragma unroll
        for (int m = 0; m < MG_MF; ++m)
#pragma unroll
            for (int n = 0; n < 4; ++n) acc[m][n] = (f32x4){0.f, 0.f, 0.f, 0.f};
        u32x4 ra[5]; f32x2_ rb0[8], rb1[8];
#define MG_LOADA(kt) do { const int kk_ = ((kt) + koff) & (nt - 1); \
            _Pragma("unroll") for (int i_ = 0; i_ < 5; ++i_) ra[i_] = *(const GAS u32x4*)(asrc + (size_t)(64 * i_) * lda + kk_ * 64); } while (0)
#define MG_LOADB(rb, kt) do { const int kk_ = ((kt) + koff) & (nt - 1); \
            _Pragma("unroll") for (int i_ = 0; i_ < 8; ++i_) rb[i_] = __builtin_nontemporal_load((const GAS f32x2_*)(wsrc + (size_t)(kk_ * 64 + i_) * LDW)); } while (0)
#define MG_WRITE(rb, st) do { PG8_LAS unsigned char* aw_ = lds + (st) * MG_A_BYTES + aoff_w; PG8_LAS unsigned char* bw_ = ldsB + (st) * MG_B_BYTES; \
            _Pragma("unroll") for (int i_ = 0; i_ < 5; ++i_) *(PG8_LAS u32x4*)(aw_ + i_ * 64 * 128) = ra[i_]; \
            u32x4 w0_, w1_; \
            w0_.x = cvt_pk_bf16(rb[0][0], rb[1][0]); w0_.y = cvt_pk_bf16(rb[2][0], rb[3][0]); w0_.z = cvt_pk_bf16(rb[4][0], rb[5][0]); w0_.w = cvt_pk_bf16(rb[6][0], rb[7][0]); \
            w1_.x = cvt_pk_bf16(rb[0][1], rb[1][1]); w1_.y = cvt_pk_bf16(rb[2][1], rb[3][1]); w1_.z = cvt_pk_bf16(rb[4][1], rb[5][1]); w1_.w = cvt_pk_bf16(rb[6][1], rb[7][1]); \
            *(PG8_LAS u32x4*)(bw_ + boff_w0) = w0_; *(PG8_LAS u32x4*)(bw_ + boff_w1) = w1_; } while (0)
#define MG_RDA(dst, st, m, swk) do { dst = *(const PG8_LAS bf16x8*)(lds + (st) * MG_A_BYTES + aoff_r + (m) * 16 * 128 + swk); } while (0)
#define MG_MM(m, Af) do { __builtin_amdgcn_s_setprio(1); _Pragma("unroll") for (int n = 0; n < 4; ++n) acc[m][n] = __builtin_amdgcn_mfma_f32_16x16x32_bf16(Bf[n], Af, acc[m][n], 0, 0, 0); __builtin_amdgcn_s_setprio(0); } while (0)
#define MG_HALF(st, swk) do { bf16x8 Bf[4], Aa, Ab; \
            _Pragma("unroll") for (int n = 0; n < 4; ++n) { const int ro_ = (MODE == 1) ? ((n & 1) * 16 + (n >> 1) * 64) * 128 : n * 16 * 128; \
                Bf[n] = *(const PG8_LAS bf16x8*)(ldsB + (st) * MG_B_BYTES + boff_r + ro_ + swk); } \
            MG_RDA(Aa, st, 0, swk); MG_RDA(Ab, st, 1, swk); \
            MG_MM(0, Aa); MG_RDA(Aa, st, 2, swk); \
            MG_MM(1, Ab); MG_RDA(Ab, st, 3, swk); \
            MG_MM(2, Aa); MG_RDA(Aa, st, 4, swk); \
            MG_MM(3, Ab); \
            MG_MM(4, Aa); } while (0)
#define MG_COMPUTE(st) do { MG_HALF(st, sw0); MG_HALF(st, sw1); } while (0)
        MG_LOADA(0); MG_LOADB(rb0, 0); MG_LOADB(rb1, 1);
        MG_WRITE(rb0, 0);
        MG_LOADA(1);
        __syncthreads();
        for (int t = 0; t < nt; t += 2) {
            MG_LOADB(rb0, t + 2);
            MG_COMPUTE(0);
            MG_WRITE(rb1, 1);
            MG_LOADA(t + 2);
            __syncthreads();
            MG_LOADB(rb1, t + 3);
            MG_COMPUTE(1);
            MG_WRITE(rb0, 0);
            MG_LOADA(t + 3);
            __syncthreads();
        }
        int ze = 0; asm volatile("" : "+v"(ze));
        bf16_t* outq = out; const float* sgq = slot_gate; asm volatile("" : "+s"(outq), "+s"(sgq));
#pragma unroll
        for (int m = 0; m < MG_MF; ++m) {
            const size_t row = (size_t)(unsigned)(mt * MT + 80 * wr + m * 16 + fr + ze);
            if (MODE == 1) {
#pragma unroll
                for (int n = 0; n < 2; ++n) {
                    const f32x4 g = acc[m][n], up = acc[m][n + 2];
                    float o[4];
#pragma unroll
                    for (int e2 = 0; e2 < 4; ++e2) o[e2] = (g[e2] / (1.f + __expf(-g[e2]))) * up[e2];
                    u32x2_ w2_; w2_.x = pk2(o[0], o[1]); w2_.y = pk2(o[2], o[3]); *(GAS u32x2_*)(outq + row * FF + 64 * pl + 32 * wc + 16 * n + 4 * fq) = w2_;
                }
            } else {
                const float gt = *(const GAS float*)(sgq + row);
#pragma unroll
                for (int n = 0; n < 4; ++n) {
                    const f32x4 v = acc[m][n] * gt;
                    u32x2_ w2_; w2_.x = pk2(v[0], v[1]); w2_.y = pk2(v[2], v[3]); *(GAS u32x2_*)(outq + row * D + 128 * pl + 64 * wc + 16 * n + 4 * fq) = w2_;
                }
            }
        }
    }
#undef MG_LOADA
#undef MG_LOADB
#undef MG_WRITE
#undef MG_COMPUTE
#undef MG_RDA
#undef MG_MM
#undef MG_HALF
}

__device__ __forceinline__ void ph_thin_win(const int tid_, const int bid_, const bf16_t* hb_gen, const bf16_t* WinT_gen, const ssq_t* ss, bf16_t* zb_gen, unsigned char* lds) {
    const GAS bf16_t* hb = (const GAS bf16_t*)hb_gen;
    const GAS bf16_t* WinT = (const GAS bf16_t*)WinT_gen;
    GAS bf16_t* zb = (GAS bf16_t*)zb_gen;

    typedef short bf16x8 __attribute__((ext_vector_type(8)));
    typedef float f32x16 __attribute__((ext_vector_type(16)));
    const int lane = tid_ & 63, wv = tid_ >> 6, l31 = lane & 31, hh = lane >> 5;
    float* part = (float*)lds;
    f32x16 acc[3];
#pragma unroll
    for (int nt = 0; nt < 3; ++nt)
#pragma unroll
        for (int e = 0; e < 16; ++e) acc[nt][e] = 0.f;
    const GAS bf16_t* ap = hb + (size_t)(bid_ * 32 + l31) * D + 256 * wv + 8 * hh;
    const GAS bf16_t* bp = WinT + (size_t)(4096 + l31) * D + 256 * wv + 8 * hh;
#pragma unroll 4
    for (int ks = 0; ks < 16; ++ks) {
        const bf16x8 a = *(const GAS bf16x8*)(ap + 16 * ks);
#pragma unroll
        for (int nt = 0; nt < 3; ++nt) {
            const bf16x8 b = *(const GAS bf16x8*)(bp + (size_t)nt * 32 * D + 16 * ks);
            acc[nt] = __builtin_amdgcn_mfma_f32_32x32x16_bf16(a, b, acc[nt], 0, 0, 0);
        }
    }
#pragma unroll
    for (int nt = 0; nt < 3; ++nt)
#pragma unroll
        for (int e = 0; e < 16; ++e) {
            const int row = (e & 3) + 8 * (e >> 2) + 4 * hh;
            part[((wv * 3 + nt) * 32 + row) * 33 + l31] = acc[nt][e];
        }
    __syncthreads();
    {
        const int row = tid_ >> 4, cg = tid_ & 15;
        const size_t grow = (size_t)bid_ * 32 + row;
        const float rs = 1.0f / sqrtf(ss_dec(ss[grow]) * (1.0f / (float)D) + EPS);
        float o[6];
#pragma unroll
        for (int c = 0; c < 6; ++c) {
            const int col = 6 * cg + c, nt = col >> 5, j = col & 31;
            float v = 0.f;
#pragma unroll
            for (int w = 0; w < 8; ++w) v += part[((w * 3 + nt) * 32 + row) * 33 + j];
            o[c] = v * rs;
        }
        GAS unsigned* dst = (GAS unsigned*)(zb + grow * DIN + 4096 + 6 * cg);
        dst[0] = pk2(o[0], o[1]); dst[1] = pk2(o[2], o[3]); dst[2] = pk2(o[4], o[5]);
    }
    __syncthreads();
}

struct MoeOrder {
    const LAS int* tile_e; int nunits, npn, c;
    __device__ __forceinline__ bool next(int i, pg8::Unit& u) const {
        const int q = i * NBLK + c; if (q >= nunits) return false;
        const int mt = q / npn, pl = q % npn; u.pm = mt; u.pn = tile_e[mt] * npn + pl; return true;
    }
    __device__ __forceinline__ void a_ready(const pg8::Unit&) const {}
    __device__ __forceinline__ void done(const pg8::Unit&) const {}
};
__device__ __forceinline__ void tr_reg(const float* W, int ldw, int k0, int n0, bf16_t* WT, size_t dstrow0, int Kpad, int lane, const float* gk = nullptr) {
    const int nq = lane >> 3, kc = lane & 7;
    const float* src = W + (size_t)(k0 + 8 * kc) * ldw + n0 + 4 * nq;
    pg8::f32x4 r[8];
#pragma unroll
    for (int i = 0; i < 8; ++i) { r[i] = *(const pg8::f32x4*)(src + (size_t)i * ldw); if (gk) r[i] = r[i] * gk[k0 + 8 * kc + i]; }
#pragma unroll
    for (int j = 0; j < 4; ++j)
        *(uint4*)(WT + (dstrow0 + 4 * nq + j) * Kpad + k0 + 8 * kc) = make_uint4(pk2(r[0][j], r[1][j]), pk2(r[2][j], r[3][j]), pk2(r[4][j], r[5][j]), pk2(r[6][j], r[7][j]));
}

template <int MODE> struct EpiG {
    static constexpr bool PERM = false, AFTER_DRAIN = false;
    float* C; int ldc; int nvalid; const float* aux; int ldaux; const float* bias; bf16_t* Cb; int ldcb; int wave_s;
    __device__ __forceinline__ void operator()(const pg8::f32x4 (&acc)[2][2][4][2], const pg8::Unit& u, int, int, int, int) const {
        EPI_DECODE();
        const int row0 = u.pm * 256 + wr * 64 + fr, col0 = u.pn * 256 + wc * 32 + fq * 4;
#pragma unroll
        for (int ai = 0; ai < 2; ++ai)
#pragma unroll
            for (int m = 0; m < 4; ++m) {
                const size_t row = (size_t)(row0 + ai * 128 + m * 16);
#pragma unroll
                for (int bj = 0; bj < 2; ++bj)
#pragma unroll
                    for (int n = 0; n < 2; ++n) {
                        const int col = col0 + bj * 128 + n * 16;
                        if (col < nvalid) {
                            const pg8::f32x4 v = acc[ai][bj][m][n];
                            if (MODE == 0) { *(GAS pg8::f32x4*)(C + row * ldc + col) = v; }
                            else if (MODE == 5) { stg8((GAS void*)(Cb + row * ldcb + col), make_uint2(pk2(v[0], v[1]), pk2(v[2], v[3]))); }
                            else if (MODE == 1) { GAS pg8::f32x4* p = (GAS pg8::f32x4*)(C + row * ldc + col); *p = *p + v; }
                            else if (MODE == 3) {
                                pg8::f32x4* p = (pg8::f32x4*)(C + row * ldc + col);
                                const pg8::f32x4 a = *(const pg8::f32x4*)(aux + row * ldaux + col);
                                pg8::f32x4 o = *p;
#pragma unroll
                                for (int e = 0; e < 4; ++e) o[e] += a[e] * (1.f / (1.f + __expf(-v[e])));
                                *p = o;
                            } else if (MODE == 4) {
                                const pg8::f32x4 a = *(const GAS pg8::f32x4*)(aux + row * ldaux + col);
                                const pg8::f32x4 b = *(const GAS pg8::f32x4*)(bias + col);
                                float o[4];
#pragma unroll
                                for (int e = 0; e < 4; ++e) o[e] = a[e] * (1.f / (1.f + __expf(-(v[e] + b[e]))));
                                stg8((GAS void*)(Cb + row * ldcb + col), make_uint2(pk2(o[0], o[1]), pk2(o[2], o[3])));
                            }
                        }
                    }
            }
    }
};


constexpr int KNP = 576;
constexpr int AK_ROW = 104, AV_ROW = 72;
constexpr int AK_BYTES = 64 * AK_ROW * 2, AV_BYTES = 64 * AV_ROW * 2;
constexpr int AV2_ROW = 136;
constexpr int AK2_BYTES = 128 * AK_ROW * 2, AV2_BYTES = 64 * AV2_ROW * 2;
__device__ __forceinline__ void ph_mla_attn_mfma(const int tid_, const int bid_, const bf16_t* qfb_gen, const bf16_t* knb_gen, const bf16_t* zb_gen, const bf16_t* vTb_gen, bf16_t* mixb_gen,
                                                 const float* cm, const float* sm, unsigned char* lds) {
    const GAS bf16_t* qfb = (const GAS bf16_t*)qfb_gen;
    const GAS bf16_t* knb = (const GAS bf16_t*)knb_gen;
    const GAS bf16_t* zb = (const GAS bf16_t*)zb_gen;
    const GAS bf16_t* vTb = (const GAS bf16_t*)vTb_gen;
    GAS bf16_t* mixb = (GAS bf16_t*)mixb_gen;

    typedef short bf16x8 __attribute__((ext_vector_type(8)));
    typedef float f32x4 __attribute__((ext_vector_type(4)));
    const int lane = tid_ & 63, wv = tid_ >> 6, li = lane & 15, lq = lane >> 4, kg = wv >> 2, qg = wv & 3;
    float* mrg = (float*)(lds + 2 * AK2_BYTES + 2 * AV2_BYTES);
    for (int r = 0; r < 3; ++r) {
        const int idx = r * NBLK + ((r & 1) ? (NBLK - 1 - bid_) : bid_);
        if (idx >= 576) break;
        const int qb = 15 - idx / 36, bh = idx % 36, b = bh / 9, h = bh % 9;
        const int q0 = qb * 128, qw = q0 + qg * 32;
        const size_t tb = (size_t)b * S;
        bf16x8 qf[2][3];
#pragma unroll
        for (int qt = 0; qt < 2; ++qt) {
#pragma unroll
            for (int ks = 0; ks < 3; ++ks) qf[qt][ks] = *(const GAS bf16x8*)(qfb + (tb + qw + 16 * qt + li) * NQ + h * 96 + 32 * ks + 8 * lq);
            {
                const uint4 w = __builtin_bit_cast(uint4, qf[qt][2]);
                float f[8], pr[8], o8[8];
                unpack8(w, f);
#pragma unroll
                for (int e = 0; e < 8; ++e) pr[e] = shflx(f[e], 32, lane);
                const size_t tq_ = tb + qw + 16 * qt + li;
                const float4 c0 = *(const float4*)(cm + tq_ * 16 + 8 * (lq & 1)), c1 = *(const float4*)(cm + tq_ * 16 + 8 * (lq & 1) + 4);
                const float4 s0 = *(const float4*)(sm + tq_ * 16 + 8 * (lq & 1)), s1 = *(const float4*)(sm + tq_ * 16 + 8 * (lq & 1) + 4);
                const float cc[8] = {c0.x, c0.y, c0.z, c0.w, c1.x, c1.y, c1.z, c1.w}, sn[8] = {s0.x, s0.y, s0.z, s0.w, s1.x, s1.y, s1.z, s1.w};
                const float sg = (lq < 2) ? -1.f : 1.f;
#pragma unroll
                for (int e = 0; e < 8; ++e) o8[e] = f[e] * cc[e] + sg * pr[e] * sn[e];
                const uint4 wo = pack8(o8);
                qf[qt][2] = __builtin_bit_cast(bf16x8, wo);
            }
        }
        f32x4 o[2][4];
#pragma unroll
        for (int qt = 0; qt < 2; ++qt)
#pragma unroll
            for (int dt = 0; dt < 4; ++dt) o[qt][dt] = (f32x4){0.f, 0.f, 0.f, 0.f};
        float mrun[2] = {-1e30f, -1e30f}, lrun[2] = {0.f, 0.f};
        const int npair = qb + 1;
        uint4 rk[3], rv[2];
#define MLA_LOAD(pr_) do { const size_t t0_ = tb + (size_t)(pr_) * 128; \
            _Pragma("unroll") for (int j_ = 0; j_ < 3; ++j_) { const int c_ = tid_ + 512 * j_, key_ = c_ / 12, part_ = c_ - 12 * key_; \
                rk[j_] = (part_ < 8) ? ldg16((const GAS void*)(knb + (t0_ + key_) * KNP + h * 64 + 8 * part_)) : ldg16((const GAS void*)(zb + (t0_ + key_) * DIN + OFF_KR + 8 * (part_ - 8))); } \
            _Pragma("unroll") for (int j_ = 0; j_ < 2; ++j_) rv[j_] = ldg16((const GAS void*)(vTb + (size_t)(h * 64 + (tid_ >> 4) + 32 * j_) * T + t0_ + 8 * (tid_ & 15))); } while (0)
#define MLA_WRITE(buf) do { unsigned char* kb_ = lds + (buf) * AK2_BYTES; unsigned char* vb_ = lds + 2 * AK2_BYTES + (buf) * AV2_BYTES; \
            _Pragma("unroll") for (int j_ = 0; j_ < 3; ++j_) { const int c_ = tid_ + 512 * j_, key_ = c_ / 12, part_ = c_ - 12 * key_; *(uint4*)(kb_ + (key_ * AK_ROW + 8 * part_) * 2) = rk[j_]; } \
            _Pragma("unroll") for (int j_ = 0; j_ < 2; ++j_) *(uint4*)(vb_ + (((tid_ >> 4) + 32 * j_) * AV2_ROW + 8 * (tid_ & 15)) * 2) = rv[j_]; } while (0)
        MLA_LOAD(0);
        __syncthreads();
        MLA_WRITE(0);
        __syncthreads();
        for (int pr = 0; pr < npair; ++pr) {
            { const int nb_ = (pr + 1 < npair) ? (pr + 1) : pr; MLA_LOAD(nb_); }
            const int k0 = pr * 128 + kg * 64;
            if (k0 <= qw + 31) {
                const unsigned char* kt = lds + (pr & 1) * AK2_BYTES + kg * (64 * AK_ROW * 2);
                const unsigned char* vt = lds + 2 * AK2_BYTES + (pr & 1) * AV2_BYTES + kg * 128;
                bf16x8 kf[4][3];
#pragma unroll
                for (int ti = 0; ti < 4; ++ti)
#pragma unroll
                    for (int ks = 0; ks < 3; ++ks) kf[ti][ks] = *(const bf16x8*)(kt + ((16 * ti + li) * AK_ROW + 32 * ks + 8 * lq) * 2);
                f32x4 sc[2][4];
#pragma unroll
                for (int qt = 0; qt < 2; ++qt)
#pragma unroll
                    for (int ti = 0; ti < 4; ++ti) {
                        sc[qt][ti] = (f32x4){0.f, 0.f, 0.f, 0.f};
#pragma unroll
                        for (int ks = 0; ks < 3; ++ks) sc[qt][ti] = __builtin_amdgcn_mfma_f32_16x16x32_bf16(kf[ti][ks], qf[qt][ks], sc[qt][ti], 0, 0, 0);
                    }
                bf16x8 vf[4][2];
#pragma unroll
                for (int dt = 0; dt < 4; ++dt)
#pragma unroll
                    for (int s2 = 0; s2 < 2; ++s2) {
                        const unsigned char* vp = vt + ((16 * dt + li) * AV2_ROW + 32 * s2 + 4 * lq) * 2;
                        const uint2 lo = *(const uint2*)vp, hi = *(const uint2*)(vp + 32);
                        const uint4 w = make_uint4(lo.x, lo.y, hi.x, hi.y);
                        vf[dt][s2] = __builtin_bit_cast(bf16x8, w);
                    }
#pragma unroll
                for (int qt = 0; qt < 2; ++qt) {
                    const int qs = qw + 16 * qt;
                    if (k0 <= qs + 15) {
                        if (k0 + 63 > qs) {
                            const int qpos = qs + li;
#pragma unroll
                            for (int ti = 0; ti < 4; ++ti)
#pragma unroll
                                for (int e = 0; e < 4; ++e) if (k0 + 16 * ti + 4 * lq + e > qpos) sc[qt][ti][e] = -1e30f;
                        }
                        float mx = -1e30f;
#pragma unroll
                        for (int ti = 0; ti < 4; ++ti)
#pragma unroll
                            for (int e = 0; e < 4; ++e) mx = fmaxf(mx, sc[qt][ti][e]);
                        mx = fmaxf(mx, shflx(mx, 16, lane)); mx = fmaxf(mx, shflx(mx, 32, lane));
                        const float mnew = fmaxf(mrun[qt], mx);
                        const float alpha = __builtin_amdgcn_exp2f(mrun[qt] - mnew);
                        float rs = 0.f;
#pragma unroll
                        for (int ti = 0; ti < 4; ++ti)
#pragma unroll
                            for (int e = 0; e < 4; ++e) { const float p = __builtin_amdgcn_exp2f(sc[qt][ti][e] - mnew); sc[qt][ti][e] = p; rs += p; }
                        rs += shflx(rs, 16, lane); rs += shflx(rs, 32, lane);
                        lrun[qt] = lrun[qt] * alpha + rs; mrun[qt] = mnew;
#pragma unroll
                        for (int dt = 0; dt < 4; ++dt) o[qt][dt] = o[qt][dt] * alpha;
                        bf16x8 pb[2];
#pragma unroll
                        for (int s2 = 0; s2 < 2; ++s2) {
                            const unsigned w0 = pk2(sc[qt][2 * s2][0], sc[qt][2 * s2][1]), w1 = pk2(sc[qt][2 * s2][2], sc[qt][2 * s2][3]);
                            const unsigned w2 = pk2(sc[qt][2 * s2 + 1][0], sc[qt][2 * s2 + 1][1]), w3 = pk2(sc[qt][2 * s2 + 1][2], sc[qt][2 * s2 + 1][3]);
                            const uint4 w = make_uint4(w0, w1, w2, w3);
                            pb[s2] = __builtin_bit_cast(bf16x8, w);
                        }
#pragma unroll
                        for (int dt = 0; dt < 4; ++dt)
#pragma unroll
                            for (int s2 = 0; s2 < 2; ++s2) o[qt][dt] = __builtin_amdgcn_mfma_f32_16x16x32_bf16(vf[dt][s2], pb[s2], o[qt][dt], 0, 0, 0);
                    }
                }
            }
            MLA_WRITE((pr + 1) & 1);
            __syncthreads();
        }
#undef MLA_LOAD
#undef MLA_WRITE
        if (kg == 1) {
#pragma unroll
            for (int qt = 0; qt < 2; ++qt) {
                float* mp = mrg + ((qg * 2 + qt) * 18) * 64 + lane;
                mp[0] = mrun[qt]; mp[64] = lrun[qt];
#pragma unroll
                for (int dt = 0; dt < 4; ++dt)
#pragma unroll
                    for (int e = 0; e < 4; ++e) mp[(2 + 4 * dt + e) * 64] = o[qt][dt][e];
            }
        }
        __syncthreads();
        if (kg == 0) {
#pragma unroll
            for (int qt = 0; qt < 2; ++qt) {
                const float* mp = mrg + ((qg * 2 + qt) * 18) * 64 + lane;
                const float m1 = mp[0], l1 = mp[64];
                const float m = fmaxf(mrun[qt], m1);
                const float a0 = __builtin_amdgcn_exp2f(mrun[qt] - m), a1 = __builtin_amdgcn_exp2f(m1 - m);
                const float inv = 1.f / (lrun[qt] * a0 + l1 * a1);
                GAS bf16_t* op = mixb + (tb + qw + 16 * qt + li) * D + 1472 + h * 64 + 4 * lq;
#pragma unroll
                for (int dt = 0; dt < 4; ++dt) {
                    float v[4];
#pragma unroll
                    for (int e = 0; e < 4; ++e) v[e] = (o[qt][dt][e] * a0 + mp[(2 + 4 * dt + e) * 64] * a1) * inv;
                    stg8((GAS void*)(op + 16 * dt), make_uint2(pk2(v[0], v[1]), pk2(v[2], v[3])));
                }
            }
        }
    }
}


struct Params {
    const float* in[33];
    float* out;
    unsigned char* ws;
};
constexpr int NIN_P = 4352, NQ_P = 1024, NKV_P = 1280;
constexpr size_t al256(size_t x) { return (x + 255) & ~(size_t)255; }
constexpr size_t WS_BAR = 0;
constexpr size_t WS_H = al256(WS_BAR + XCD_BAR_WORDS * 4);
constexpr size_t WS_HN = WS_H + (size_t)T * D * 4;
constexpr size_t WS_Z = WS_HN + (size_t)T * D * 4;
constexpr size_t WS_QM = WS_Z + (size_t)T * DIN * 4;
constexpr size_t WS_KVM = WS_QM + (size_t)T * NQ * 4;
constexpr size_t WS_QF = WS_KVM + (size_t)T * NKV * 4;
constexpr size_t WS_KRF = WS_QF + (size_t)T * NQ * 4;
constexpr size_t WS_QD = WS_KRF + (size_t)T * 32 * 4;
constexpr size_t WS_KD = WS_QD + (size_t)T * DILD * 4;
constexpr size_t WS_OD = WS_KD + (size_t)T * DILD * 4;
constexpr size_t WS_LSE = WS_OD + (size_t)T * DILD * 4;
constexpr size_t WS_X = al256(WS_LSE + (size_t)T * 9 * 4);
constexpr size_t WS_CI = WS_X + (size_t)NB * NG * NCH * 128 * 4;
constexpr size_t WS_GV = WS_CI + (size_t)NB * NG * NCH * 128 * 4;
constexpr size_t WS_CD = WS_GV + (size_t)T * SSMD * 4;
constexpr size_t WS_SD = WS_CD + (size_t)T * 8 * 4;
constexpr size_t WS_CM = WS_SD + (size_t)T * 8 * 4;
constexpr size_t WS_SM = WS_CM + (size_t)T * 16 * 4;
constexpr size_t WS_PPROJ = WS_SM + (size_t)T * 16 * 4;
constexpr size_t WS_EIDX = WS_PPROJ + (size_t)T * D * 4;
constexpr size_t WS_GATE = WS_EIDX + (size_t)T * 2 * 4;
constexpr size_t WS_CNT = WS_GATE + (size_t)T * 2 * 4;
constexpr size_t WS_CURSOR = WS_CNT + 256;
constexpr size_t WS_PSTART = WS_CURSOR + 256;
constexpr size_t WS_TILEE = WS_PSTART + 512;
constexpr size_t WS_SLOTGATE = al256(WS_TILEE + (NTILE + 1) * 4);
constexpr size_t WS_TOKSLOT = WS_SLOTGATE + (size_t)PSLOT * 4;
constexpr size_t WS_AG = WS_TOKSLOT + (size_t)T * 2 * 4;
constexpr size_t WS_ACTB = WS_AG + (size_t)PSLOT * D * 2;
constexpr size_t WS_YB = WS_ACTB + (size_t)PSLOT * FF * 2;
constexpr size_t WS_W1T = WS_YB + (size_t)PSLOT * D * 2;
constexpr size_t WS_W2T = WS_W1T + (size_t)NE * 2 * FF * D * 2;
constexpr size_t WS_HNB = WS_W2T + (size_t)NE * D * FF * 2;
constexpr size_t WS_MIXB = WS_HNB + (size_t)T * D * 2;
constexpr size_t WS_NQB = WS_MIXB + (size_t)T * D * 2;
constexpr size_t WS_NKVB = WS_NQB + (size_t)T * QR * 2;
constexpr size_t WS_GVB = WS_NKVB + (size_t)T * KVR * 2;
constexpr size_t WS_PB = WS_GVB + (size_t)T * GLU_P * 2;
constexpr size_t WS_WIN = WS_PB + (size_t)DEPTH * T * PLE * 2;
constexpr size_t WS_WOUT = WS_WIN + (size_t)DEPTH * NIN_P * D * 2;
constexpr size_t WS_WPG = WS_WOUT + (size_t)DEPTH * D * D * 2;
constexpr size_t WS_WPP = WS_WPG + (size_t)DEPTH * D * D * 2;
constexpr size_t WS_WUQ = WS_WPP + (size_t)DEPTH * D * PLE * 2;
constexpr size_t WS_WUKV = WS_WUQ + (size_t)DEPTH * NQ_P * QR * 2;
constexpr size_t WS_WGLU = WS_WUKV + (size_t)DEPTH * NKV_P * KVR * 2;
constexpr size_t WS_WKT = WS_WGLU + (size_t)DEPTH * GLU_P * GLU_P * 2;
constexpr size_t WS_WVT = WS_WKT + (size_t)DEPTH * 768 * KVR * 2;
constexpr size_t WS_QFB = WS_WVT + (size_t)DEPTH * 768 * KVR * 2;
constexpr size_t WS_KNB = WS_QFB + (size_t)T * NQ * 2;
constexpr size_t WS_KRB = WS_KNB + (size_t)T * KNP * 2;
constexpr size_t WS_VTB = WS_KRB + (size_t)T * 32 * 2;
constexpr size_t WS_W2R = WS_VTB + (size_t)768 * T * 2;
constexpr size_t WS_RSBUF = WS_W2R + (size_t)DEPTH * D * RCOLS * 4;
constexpr size_t WS_SS = WS_RSBUF + (size_t)T * 4;
constexpr size_t WS_RSQ = WS_SS + (size_t)3 * T * 8;
constexpr size_t WS_RSKV = WS_RSQ + (size_t)T * 4;
constexpr size_t WS_HB = WS_RSKV + (size_t)T * 4;
constexpr size_t WS_DQB = WS_HB + (size_t)T * D * 2;
constexpr size_t WS_DKB = WS_DQB + (size_t)T * DILD * 2;
constexpr size_t WS_DVB = WS_DKB + (size_t)T * DILD * 2;
constexpr size_t WS_END = WS_DVB + (size_t)T * DILD * 2;

constexpr int LDS_SCR = 0;
constexpr int LDS_XB = 131072;
constexpr int LDS_INP = LDS_XB + 16;
constexpr int LDS_LG = LDS_INP + 288;
constexpr int LDS_PS = LDS_LG + 2304;
constexpr int LDS_TILEE = LDS_PS + 272;
constexpr int LDS_BYTES = 147456;

__global__ void __launch_bounds__(NTHR, 2) mega(Params P) {
    extern __shared__ __attribute__((aligned(16))) unsigned char smem[];
    uint4* xb_words = (uint4*)(smem + LDS_XB);
    unsigned long long* inp = (unsigned long long*)(smem + LDS_INP);
    float (*As)[132] = (float (*)[132])(smem + LDS_SCR);
    float (*Bs)[68] = (float (*)[68])(smem + LDS_SCR + 16 * 132 * 4);
    float (*lg)[72] = (float (*)[72])(smem + LDS_LG);
    int* ps = (int*)(smem + LDS_PS);
    if (threadIdx.x == 0) {
        *xb_words = make_uint4(0u, 0u, 0u, 0u);
#pragma unroll
        for (int i = 0; i < 33; ++i) inp[i] = (unsigned long long)P.in[i];
        inp[33] = (unsigned long long)P.out;
        inp[34] = (unsigned long long)P.ws;
    }
    __syncthreads();
    const unsigned smem_base = (unsigned)(size_t)(LAS unsigned char*)smem;
#define LDP(i) ({ unsigned b_ = smem_base; asm volatile("" : "+s"(b_)); const unsigned long long v_ = *(LAS unsigned long long*)(b_ + LDS_INP + 8 * (i)); \
        ((unsigned long long)(unsigned)__builtin_amdgcn_readfirstlane((int)(unsigned)v_) | ((unsigned long long)(unsigned)__builtin_amdgcn_readfirstlane((int)(unsigned)(v_ >> 32)) << 32)); })
#define INP(i) ((const float*)LDP(i))
#define WSF(off) ((float*)(LDP(34) + (off)))
#define WSI(off) ((int*)(LDP(34) + (off)))
#define WSB(off) ((bf16_t*)(LDP(34) + (off)))
#define LAUNDER() unsigned z_ = 0u; asm volatile("" : "+s"(z_)); int ws_ = wave_s; asm volatile("" : "+s"(ws_)); int tid_ = (ws_ << 6) | (int)__builtin_amdgcn_mbcnt_hi(~0u, __builtin_amdgcn_mbcnt_lo(~0u, z_)); asm volatile("" : "+v"(tid_)); int bid_ = blockIdx.x; asm volatile("" : "+s"(bid_));
    const int wave_s = __builtin_amdgcn_readfirstlane((int)(threadIdx.x >> 6));
    XcdBarrier bar = xcd_barrier_post((unsigned*)(P.ws + WS_BAR), (volatile LAS unsigned*)(smem + LDS_XB), (int)threadIdx.x);
#define BAR() do { LAUNDER(); XcdBarrier b_; b_.bar = (unsigned*)(LDP(34) + WS_BAR); unsigned bx_ = bar.x; asm volatile("" : "+s"(bx_)); b_.x = bx_; b_.st = bar.st; xcd_barrier(b_, tid_); } while (0)
#define PG8_RUN(MODE, Aptr, Bptr, Mv, Nv, Kv, ldav, ldbv, EPI_INIT) do { LAUNDER(); \
        pg8::Gemm g_{(const bf16_t*)(Aptr), (const bf16_t*)(Bptr), (Mv), (Nv), (Kv), (ldav), (ldbv)}; \
        pg8::StaticOrder S_; S_.init((Mv), (Nv), NBLK, bid_); \
        EpiG<MODE> E_ EPI_INIT; \
        pg8::gemm_phase<EpiG<MODE>, pg8::StaticOrder, true, true>(tid_, (PG8_LAS unsigned char*)(smem + LDS_SCR), g_, S_, E_); } while (0)

    {
        LAUNDER();
        const float* x = INP(0);
        ph_init_rows(tid_, bid_, x, INP(3), WSF(WS_H), WSB(WS_HB), (ssq_t*)WSF(WS_SS));
        for (long i = GTID(); i < (long)2 * T; i += GSTRIDE()) ((ssq_t*)WSF(WS_SS))[T + i] = 0ull;
        const float* pp = INP(1);
        for (long i = GTID(); i < (long)DEPTH * T * PLE / 2; i += GSTRIDE()) { const float2 v = ((const float2*)pp)[i]; ((unsigned*)WSB(WS_PB))[i] = pk2(v.x, v.y); }
        for (long i = GTID(); i < (long)T * 64; i += GSTRIDE()) WSB(WS_GVB)[(i >> 6) * GLU_P + 448 + (i & 63)] = 0;
    }
    { LAUNDER(); ph_rope_tab(tid_, bid_, (const int*)INP(2), WSF(WS_CD), WSF(WS_SD), WSF(WS_CM), WSF(WS_SM)); }
    {
        LAUNDER();
        for (long i = GTID(); i < (long)DEPTH * D * RCOLS; i += GSTRIDE()) {
            const int Lw = (int)(i / (D * RCOLS)); int r = (int)(i % (D * RCOLS));
            const int j = r & 7; r >>= 3; const int jc = r & 15; r >>= 4; const int q = r & 3; r >>= 2; const int nb = r % 5; r /= 5; const int sst = r & 15, kq4 = r >> 4;
            const int k = 512 * kq4 + 32 * sst + 8 * q + j, col = 16 * nb + jc;
            float v = 0.f;
            if (col < 64) v = INP(24)[(size_t)Lw * D * NE + (size_t)k * NE + col];
            else if (col < 72) v = INP(22)[(size_t)Lw * D * 8 + (size_t)k * 8 + (col - 64)];
            v *= INP(21)[(size_t)Lw * D + k];
            const unsigned hb_ = f2bf(v);
            const unsigned lb_ = f2bf(v - __builtin_bit_cast(float, hb_ << 16));
            bf16_t* dst = (bf16_t*)WSF(WS_W2R) + (size_t)Lw * D * RCOLS * 2;
            const size_t base = ((size_t)((kq4 * 16 + sst) * 5 + nb) * 2) * 512 + (size_t)(16 * q + jc) * 8 + j;
            dst[base] = (bf16_t)hb_; dst[base + 512] = (bf16_t)lb_;
        }
    }
    {
        LAUNDER();
        const int wave = tid_ >> 6, lane = tid_ & 63;
        const int gw = bid_ * 8 + wave, NGW = NBLK * 8;
        constexpr int I_IN = (D / 64) * (DIN / 32), I_OUT = (D / 64) * (D / 32), I_PG = I_OUT, I_PP = (PLE / 64) * (D / 32),
                      I_UQ = (QR / 64) * (NQ / 32), I_GLU = (SSMD / 64) * (SSMD / 32);
        constexpr int I_LAYER = I_IN + I_OUT + I_PG + I_PP + I_UQ + I_GLU;
        for (int it = gw; it < DEPTH * I_LAYER; it += NGW) {
            const int L = it / I_LAYER; int r = it % I_LAYER;
            if (r < I_IN) { const int nbk = DIN / 32; tr_reg(INP(4) + (size_t)L * D * DIN, DIN, 64 * (r / nbk), 32 * (r % nbk), WSB(WS_WIN) + (size_t)L * NIN_P * D, 32 * (r % nbk), D, lane); continue; } r -= I_IN;
            if (r < I_OUT) { const int nbk = D / 32; tr_reg(INP(20) + (size_t)L * D * D, D, 64 * (r / nbk), 32 * (r % nbk), WSB(WS_WOUT) + (size_t)L * D * D, 32 * (r % nbk), D, lane); continue; } r -= I_OUT;
            if (r < I_PG) { const int nbk = D / 32; tr_reg(INP(31) + (size_t)L * D * D, D, 64 * (r / nbk), 32 * (r % nbk), WSB(WS_WPG) + (size_t)L * D * D, 32 * (r % nbk), D, lane); continue; } r -= I_PG;
            if (r < I_PP) { const int nbk = D / 32; tr_reg(INP(30) + (size_t)L * PLE * D, D, 64 * (r / nbk), 32 * (r % nbk), WSB(WS_WPP) + (size_t)L * D * PLE, 32 * (r % nbk), PLE, lane); continue; } r -= I_PP;
            if (r < I_UQ) { const int nbk = NQ / 32; tr_reg(INP(17) + (size_t)L * QR * NQ, NQ, 64 * (r / nbk), 32 * (r % nbk), WSB(WS_WUQ) + (size_t)L * NQ_P * QR, 32 * (r % nbk), QR, lane, INP(16) + (size_t)L * QR); continue; } r -= I_UQ;
            { const int nbk = SSMD / 32; tr_reg(INP(14) + (size_t)L * SSMD * SSMD, SSMD, 64 * (r / nbk), 32 * (r % nbk), WSB(WS_WGLU) + (size_t)L * GLU_P * GLU_P, 32 * (r % nbk), GLU_P, lane); }
        }
        for (int it = gw; it < DEPTH * 2 * 4 * 18; it += NGW) {
            const int L = it / 144, r = it % 144, sel = r / 72, kb = (r % 72) / 18, nbp = r % 18, h = nbp >> 1, d0 = (nbp & 1) * 32;
            tr_reg(INP(19) + (size_t)L * KVR * NKV, NKV, 64 * kb, h * 128 + sel * 64 + d0, WSB(sel ? WS_WVT : WS_WKT) + (size_t)L * 768 * KVR, 32 * nbp, KVR, lane, INP(18) + (size_t)L * KVR);
        }
        for (long i = GTID(); i < (long)DEPTH * 2 * 192 * KVR / 8; i += GSTRIDE()) {
            const int per = 192 * KVR / 8; const int m = (int)(i / per), w = (int)(i % per);
            *(uint4*)(WSB(WS_WKT) + (size_t)m * 768 * KVR + (size_t)576 * KVR + (size_t)w * 8) = make_uint4(0, 0, 0, 0);
        }
    }
    BAR();
    for (int L0 = 0; L0 < DEPTH; ++L0) {
#define L ({ int l_ = L0; asm volatile("" : "+s"(l_)); l_; })
        { LAUNDER(); if (bid_ == 0 && tid_ < NE) { WSI(WS_CNT)[tid_] = 0; WSI(WS_CURSOR)[tid_] = 0; } }
        {
            LAUNDER();
            pg8::Gemm g_{WSB(WS_HB), WSB(WS_WIN) + (size_t)L * NIN_P * D, T, 4096, D, D, D};
            pg8::StaticOrder S_; S_.init(T, 4096, NBLK, bid_);
            EpiZ E_{WSB(WS_Z), DIN, 4096, (const ssq_t*)WSF(WS_SS) + (size_t)L * T, wave_s};
            pg8::gemm_phase<EpiZ, pg8::StaticOrder, true, true>(tid_, (PG8_LAS unsigned char*)(smem + LDS_SCR), g_, S_, E_);
        }
        { LAUNDER(); ph_thin_win(tid_, bid_, WSB(WS_HB), WSB(WS_WIN) + (size_t)L * NIN_P * D, (const ssq_t*)WSF(WS_SS) + (size_t)L * T, WSB(WS_Z), smem + LDS_SCR); }
        PG8_RUN(5, WSB(WS_PB) + (size_t)L * T * PLE, WSB(WS_WPP) + (size_t)L * D * PLE, T, D, PLE, PLE, PLE, ({nullptr, D, D, nullptr, 0, nullptr, (bf16_t*)WSF(WS_PPROJ), D, wave_s}));
        BAR();
        { LAUNDER(); ph_light(tid_, bid_, WSB(WS_Z), INP(5) + (size_t)L * 3 * CONVD, WSF(WS_CD), WSF(WS_SD), WSF(WS_CM), WSF(WS_SM), WSB(WS_MIXB), WSF(WS_RSQ), WSF(WS_RSKV)); }
        { LAUNDER(); ph_ssm_local(tid_, bid_, WSB(WS_Z), INP(6) + (size_t)L * NG * NP, INP(7) + (size_t)L * NG * NP, INP(8) + (size_t)L * NG,
                                  INP(9) + (size_t)L * NG * NP * 16, INP(10) + (size_t)L * NG * NP * 16, WSF(WS_X), smem + LDS_SCR); }
        BAR();
        { LAUNDER(); ph_dil_attn_mfma(tid_, bid_, WSB(WS_Z), WSF(WS_OD), WSF(WS_LSE), smem + LDS_SCR); }
        {
            LAUNDER();
            if (bid_ < 128) {
            pg8::Gemm g_{WSB(WS_Z) + OFF_CQ, WSB(WS_WUQ) + (size_t)L * NQ_P * QR, T, NQ_P, QR, DIN, QR};
            pg8::StaticOrder S_; S_.init(T, NQ_P, 128, bid_);
            EpiB16S E_{WSB(WS_QFB), NQ, NQ, WSF(WS_RSQ), nullptr, 0.10206207261596575f * 1.4426950408889634f, wave_s};
            pg8::gemm_phase<EpiB16S, pg8::StaticOrder, true, true>(tid_, (PG8_LAS unsigned char*)(smem + LDS_SCR), g_, S_, E_);
            }
        }
        {
            LAUNDER();
            if (bid_ >= 128 && bid_ < 192) {
            pg8::Gemm g_{WSB(WS_Z) + OFF_CKV, WSB(WS_WKT) + (size_t)L * 768 * KVR, T, 768, KVR, DIN, KVR};
            pg8::StaticOrder S_; S_.init(T, 768, 64, bid_ - 128);
            EpiB16S E_{WSB(WS_KNB), KNP, KNP, WSF(WS_RSKV), nullptr, 1.f, wave_s};
            pg8::gemm_phase<EpiB16S, pg8::StaticOrder, true, true>(tid_, (PG8_LAS unsigned char*)(smem + LDS_SCR), g_, S_, E_);
            }
        }
        {
            LAUNDER();
            if (bid_ >= 192) {
            pg8::Gemm g_{WSB(WS_WVT) + (size_t)L * 768 * KVR, WSB(WS_Z) + OFF_CKV, 768, T, KVR, KVR, DIN};
            pg8::StaticOrder S_; S_.init(768, T, 64, bid_ - 192);
            EpiB16S E_{WSB(WS_VTB), T, T, nullptr, WSF(WS_RSKV), 1.f, wave_s};
            pg8::gemm_phase<EpiB16S, pg8::StaticOrder, true, true>(tid_, (PG8_LAS unsigned char*)(smem + LDS_SCR), g_, S_, E_);
            }
        }
        { LAUNDER(); ph_ssm_final(tid_, bid_, WSB(WS_Z), INP(6) + (size_t)L * NG * NP, INP(7) + (size_t)L * NG * NP, INP(8) + (size_t)L * NG,
                                  INP(9) + (size_t)L * NG * NP * 16, INP(10) + (size_t)L * NG * NP * 16, INP(11) + (size_t)L * NG * 16 * NP, INP(12) + (size_t)L * NG * 16 * NP,
                                  INP(13) + (size_t)L * SSMD, WSF(WS_X), WSF(WS_GV), WSB(WS_GVB), smem + LDS_SCR); }
        BAR();
        {
            LAUNDER();
            if (bid_ >= 192) {
            pg8::Gemm g_{WSB(WS_GVB), WSB(WS_WGLU) + (size_t)L * GLU_P * GLU_P, T, GLU_P, GLU_P, GLU_P, GLU_P};
            pg8::StaticOrder S_; S_.init(T, GLU_P, 64, bid_ - 192);
            EpiG<4> E_({nullptr, 0, SSMD, WSF(WS_GV), SSMD, INP(15) + (size_t)L * SSMD, WSB(WS_MIXB) + 448, D, wave_s});
            pg8::gemm_phase<EpiG<4>, pg8::StaticOrder, true, true>(tid_, (PG8_LAS unsigned char*)(smem + LDS_SCR), g_, S_, E_);
            }
        }
        { LAUNDER(); ph_dil_combine(tid_, bid_, WSF(WS_OD), WSF(WS_LSE), WSB(WS_MIXB)); }
        { LAUNDER(); ph_mla_attn_mfma(tid_, bid_, WSB(WS_QFB), WSB(WS_KNB), WSB(WS_Z), WSB(WS_VTB), WSB(WS_MIXB), WSF(WS_CM), WSF(WS_SM), smem + LDS_SCR); }
        BAR();
        PG8_RUN(1, WSB(WS_MIXB), WSB(WS_WOUT) + (size_t)L * D * D, T, D, D, D, D, ({WSF(WS_H), D, D, nullptr, 0, nullptr, nullptr, 0, wave_s}));
        BAR();
        { LAUNDER(); ph_router_mfma(tid_, bid_, WSF(WS_H), WSF(WS_W2R) + (size_t)L * D * RCOLS, INP(23) + (size_t)L * 8, INP(25) + (size_t)L * NE,
                                    WSI(WS_EIDX), WSF(WS_GATE), WSF(WS_RSBUF), WSI(WS_CNT), smem + LDS_SCR); }
        BAR();
        { LAUNDER(); ph_moe_scatter(tid_, bid_, WSI(WS_EIDX), WSF(WS_GATE), WSI(WS_CNT), WSI(WS_CURSOR), WSF(WS_H), WSF(WS_RSBUF), INP(21) + (size_t)L * D,
                                    WSB(WS_AG), WSF(WS_SLOTGATE), WSI(WS_TOKSLOT), ps, (int*)(smem + LDS_TILEE)); }
        BAR();
        {
            LAUNDER();
            moe_gemm<1>(tid_, bid_, (const LAS int*)(smem_base + LDS_TILEE), WSB(WS_AG), D, D, INP(26) + (size_t)L * NE * D * FF, INP(27) + (size_t)L * NE * D * FF,
                        WSB(WS_ACTB), nullptr, (PG8_LAS unsigned char*)(smem + LDS_SCR));
        }
        BAR();
        {
            LAUNDER();
            moe_gemm<2>(tid_, bid_, (const LAS int*)(smem_base + LDS_TILEE), WSB(WS_ACTB), FF, FF, INP(28) + (size_t)L * NE * FF * D, nullptr,
                        WSB(WS_YB), WSF(WS_SLOTGATE), (PG8_LAS unsigned char*)(smem + LDS_SCR));
        }
        BAR();
        { LAUNDER(); ph_moe_combine_norm(tid_, bid_, WSF(WS_H), WSB(WS_YB), WSI(WS_TOKSLOT), INP(29) + (size_t)L * D, WSB(WS_HNB)); }
        BAR();
        {
            LAUNDER();
            pg8::Gemm g_{WSB(WS_HNB), WSB(WS_WPG) + (size_t)L * D * D, T, D, D, D, D};
            pg8::StaticOrder S_; S_.init(T, D, NBLK, bid_);
            EpiPle E_{WSF(WS_H), (const bf16_t*)WSF(WS_PPROJ), (L0 == 0) ? (INP(3) + D) : INP(32), WSB(WS_HB), (ssq_t*)WSF(WS_SS) + (size_t)(L + 1) * T, wave_s};
            pg8::gemm_phase<EpiPle, pg8::StaticOrder, true, true>(tid_, (PG8_LAS unsigned char*)(smem + LDS_SCR), g_, S_, E_);
        }
        BAR();
    }
#undef L
    { LAUNDER(); ph_final_norm(tid_, bid_, WSF(WS_H), (const ssq_t*)WSF(WS_SS) + (size_t)2 * T, INP(32), (float*)LDP(33)); }
}
}

extern "C" void kernel_launch(void* const* d_in, const int* in_sizes, int n_in, void* d_out, int out_size, void* d_ws, size_t ws_size,
                              hipStream_t stream) {
    static int grid = 0;
    if (!grid) {
        int dev = 0, cus = 0, per_cu = 0;
        (void)hipGetDevice(&dev);
        (void)hipDeviceGetAttribute(&cus, hipDeviceAttributeMultiprocessorCount, dev);
        if (hipFuncSetAttribute((const void*)mega, hipFuncAttributeMaxDynamicSharedMemorySize, LDS_BYTES) != hipSuccess) fprintf(stderr, "hipFuncSetAttribute failed\n");
        (void)hipOccupancyMaxActiveBlocksPerMultiprocessor(&per_cu, (const void*)mega, NTHR, LDS_BYTES);
        if (per_cu < 1) fprintf(stderr, "occupancy query returned %d\n", per_cu);
        (void)hipGetLastError();
        grid = NBLK;
        if (cus != NBLK) fprintf(stderr, "expected %d CUs, got %d\n", NBLK, cus);
    }
    Params P{};
    for (int i = 0; i < 33; ++i) P.in[i] = (const float*)d_in[i];
    P.out = (float*)d_out;
    P.ws = (unsigned char*)d_ws;
    if (ws_size < WS_END) fprintf(stderr, "ws too small: %zu < %zu\n", ws_size, (size_t)WS_END);
    (void)hipMemsetAsync((char*)d_ws + WS_BAR, 0, XCD_BAR_WORDS * 4, stream);
    hipLaunchKernelGGL(mega, dim3(grid), dim3(NTHR), LDS_BYTES, stream, P);
}
```

```cpp
#include <hip/hip_runtime.h>
#include <stdint.h>
#include <cstdio>

#define XB_TMO      128
#define XB_XCNT(j)  (256  + 64 * (j))
#define XB_XSUB(j)  (1280 + 64 * (j))
#define XB_XGEN(j)  (2304 + 64 * (j))
#define XB_TOP      3328
#define XB_TOPGEN   3392
#define XCD_BAR_WORDS 3456
#define XB_SPIN_CAP (1u << 22)
#define LAS __attribute__((address_space(3)))

__device__ __forceinline__ unsigned xb_ld(unsigned* p)              { return __hip_atomic_load(p, __ATOMIC_RELAXED, __HIP_MEMORY_SCOPE_AGENT); }
__device__ __forceinline__ unsigned xb_add(unsigned* p, unsigned v) { return __hip_atomic_fetch_add(p, v, __ATOMIC_RELAXED, __HIP_MEMORY_SCOPE_AGENT); }
__device__ __forceinline__ unsigned xb_xcc_id() { return (unsigned)__builtin_amdgcn_s_getreg((3 << 11) | 20) & 0xFu; }
#define XB_SPIN(cond, bar) do { unsigned _sp = 0; while (cond) { __builtin_amdgcn_s_sleep(1); \
    if ((++_sp & 255u) == 0u) { if (xb_ld(&(bar)[XB_TMO])) break; if (_sp > XB_SPIN_CAP) { atomicAdd(&(bar)[XB_TMO], 1u); break; } } } } while (0)

struct XcdBarrier { unsigned* bar; unsigned x; volatile LAS unsigned* st; };

__device__ __forceinline__ XcdBarrier xcd_barrier_post(unsigned* bar, volatile LAS unsigned* st, const int tid) {
    XcdBarrier b; b.bar = bar; b.x = xb_xcc_id(); b.st = st;
    if (tid == 0) (void)xb_add(&bar[XB_XCNT(b.x)], 1u);
    return b;
}
__device__ __forceinline__ void xcd_barrier_complete(unsigned* bar, unsigned x, unsigned& nloc, unsigned& nx) {
    const unsigned G = gridDim.x * gridDim.y * gridDim.z;
    unsigned sum, cnt, mine, sp = 0u;
    for (;;) {
        sum = 0u; cnt = 0u; mine = 0u;
#pragma unroll
        for (unsigned j = 0; j < 16; ++j) { const unsigned c = xb_ld(&bar[XB_XCNT(j)]); sum += c; cnt += (c > 0u) ? 1u : 0u; mine = (j == x) ? c : mine; }
        if (sum == G) break;
        __builtin_amdgcn_s_sleep(1);
        if ((++sp & 255u) == 0u) { if (xb_ld(&bar[XB_TMO])) break; if (sp > XB_SPIN_CAP) { atomicAdd(&bar[XB_TMO], 1u); break; } }
    }
    nloc = mine > 0u ? mine : 1u; nx = cnt > 0u ? cnt : 1u;
}
__device__ __forceinline__ void xcd_barrier(const XcdBarrier& b, const int tid) {
    asm volatile("s_waitcnt vmcnt(0)" ::: "memory");
    __syncthreads();
    if (tid == 0) {
        unsigned* bar = b.bar;
        __builtin_amdgcn_s_waitcnt(0);
        unsigned nloc = b.st[0], nx = b.st[1];
        if (nloc == 0u) { xcd_barrier_complete(bar, b.x, nloc, nx); b.st[0] = nloc; b.st[1] = nx; }
        const unsigned old = xb_add(&bar[XB_XSUB(b.x)], 1u);
        const unsigned gen = old / nloc;
        if (old + 1u == (gen + 1u) * nloc) {
            __builtin_amdgcn_fence(__ATOMIC_RELEASE, "agent");
            asm volatile("s_waitcnt vmcnt(0)" ::: "memory");
            const unsigned og = xb_add(&bar[XB_TOP], 1u);
            const unsigned tg = og / nx;
            if (og + 1u == (tg + 1u) * nx) xb_add(&bar[XB_TOPGEN], 1u);
            else XB_SPIN(xb_ld(&bar[XB_TOPGEN]) == tg, bar);
            __builtin_amdgcn_fence(__ATOMIC_ACQUIRE, "agent");
            xb_add(&bar[XB_XGEN(b.x)], 1u);
            asm volatile("s_waitcnt vmcnt(0)" ::: "memory");
        } else {
            XB_SPIN(xb_ld(&bar[XB_XGEN(b.x)]) == gen, bar);
            __builtin_amdgcn_fence(__ATOMIC_ACQUIRE, "agent");
            asm volatile("s_waitcnt vmcnt(0)" ::: "memory");
        }
    }
    __syncthreads();
}

namespace pg8 {
#define PG8_LAS __attribute__((address_space(3)))
typedef unsigned short bf16_t;
typedef short bf16x8 __attribute__((ext_vector_type(8)));
typedef float f32x4 __attribute__((ext_vector_type(4)));
typedef unsigned u32x4 __attribute__((ext_vector_type(4)));
constexpr int BM = 256, BK = 64, HALF = 128, HTB = HALF * BK * 2  , STAGE_BYTES = 8 * HTB, NXCD = 8, WGM = 8;

__host__ __device__ __forceinline__ int lds_byte(int r, int c) { const int st = (r >> 4) * 2 + (c >> 5), rr = r & 15, cc = c & 31, ob = rr * 64 + cc * 2; return st * 1024 + (ob ^ (((ob >> 9) & 1) << 5)); }
__host__ __device__ __forceinline__ void stage_rc(int b, int& R, int& C) { const int st = b / 1024, sb = b % 1024, swz = sb ^ (((sb >> 9) & 1) << 5); R = (st >> 1) * 16 + swz / 64; C = (st & 1) * 32 + (swz % 64) / 2; }
__host__ __device__ __forceinline__ int perm32(int rho) { const int n = rho >> 4, i = rho & 15; return 8 * (i >> 2) + 4 * n + (i & 3); }

struct Unit { int pm, pn; };
struct Gemm { const bf16_t* A; const bf16_t* Bt; int M, N, K, lda, ldb; };

struct StaticOrder {
    int nM, nN, nwg, G, c;
    __host__ __device__ void init(int M, int N, int G_, int c_) { nM = M / BM; nN = N / BM; nwg = nM * nN; G = G_; c = c_; }
    __host__ __device__ bool next(int i, Unit& u) const {
        const long L = (long)i * G + c; if (L >= nwg) return false;
        int wgid = (int)L; { const int q = nwg / NXCD, r = nwg % NXCD, xcd = wgid % NXCD, off = wgid / NXCD; wgid = (xcd < r ? xcd * (q + 1) : r * (q + 1) + (xcd - r) * q) + off; }
        const int nig = WGM * nN, gid = wgid / nig, fm = gid * WGM, gsz = (nM - fm) < WGM ? (nM - fm) : WGM;
        u.pm = fm + ((wgid % nig) % gsz); u.pn = (wgid % nig) / gsz; return true;
    }
    __device__ __forceinline__ void a_ready(const Unit&) const {}
    __device__ __forceinline__ void done(const Unit&) const {}
};

typedef __bf16 bf16x2_pg __attribute__((ext_vector_type(2)));
typedef float f32x2_pg __attribute__((ext_vector_type(2)));
__device__ __forceinline__ unsigned cvt_pk_bf16(float lo, float hi) { const f32x2_pg v = {lo, hi}; return __builtin_bit_cast(unsigned, __builtin_convertvector(v, bf16x2_pg)); }
template <class Epi, class Sched, bool ALIGN_EPI = false, bool SP2 = false>
__device__ __forceinline__ void gemm_phase(const int tid_in, PG8_LAS unsigned char* lds, const Gemm g, const Sched& S, const Epi& E) {
    const int tid = tid_in, wid = __builtin_amdgcn_readfirstlane(tid >> 6), lane = tid & 63, wr = wid >> 2, wc = wid & 3, fr = lane & 15, fq = lane >> 4;
    const int K = g.K, nt = K / BK;
    unsigned voffA[2], voffB[2];
#pragma unroll
    for (int i = 0; i < 2; ++i) { int R, C; stage_rc(tid * 16 + i * 8192, R, C); const int Rb = Epi::PERM ? ((R & ~31) + perm32(R & 31)) : R;
        voffA[i] = (unsigned)(R * g.lda + C) * 2u; voffB[i] = (unsigned)(Rb * g.ldb + C) * 2u; }
    const size_t kstep = (size_t)(BK * 2);
    const size_t hstepA = (size_t)HALF * g.lda * 2, hstepB = (size_t)HALF * g.ldb * 2;
    const size_t tstepA = 2 * hstepA, tstepB = 2 * hstepB;
    const unsigned ldsw = (unsigned)wid * 1024u;
    const int aoff = lds_byte(wr * 64 + fr, fq * 8), boff = lds_byte(wc * 32 + fr, fq * 8);
#define PG8_SA(b, h) (((b) * 2 + (h)) * HTB)
#define PG8_SB(b, h) ((4 + (b) * 2 + (h)) * HTB)
#define PG8_STAGE(bufoff, gbase, voff) do { _Pragma("unroll") for (int _i = 0; _i < 2; ++_i) \
        __builtin_amdgcn_global_load_lds((const unsigned*)((const char*)(gbase) + (voff)[_i]), (PG8_LAS unsigned*)(lds + (bufoff) + ldsw + _i * 8192), 16, 0, 0); } while (0)
#define PG8_LDA(dst, b, h) do { _Pragma("unroll") for (int m = 0; m < 4; ++m) _Pragma("unroll") for (int k = 0; k < 2; ++k) dst[m][k] = *(const PG8_LAS bf16x8*)(lds + PG8_SA(b, h) + aoff + m * 2048 + k * 1024); } while (0)
#define PG8_LDB(dst, b, h) do { _Pragma("unroll") for (int n = 0; n < 2; ++n) _Pragma("unroll") for (int k = 0; k < 2; ++k) dst[n][k] = *(const PG8_LAS bf16x8*)(lds + PG8_SB(b, h) + boff + n * 2048 + k * 1024); } while (0)
#define PG8_MMA(ai, bj, At, Bt) do { __builtin_amdgcn_s_setprio(1); _Pragma("unroll") for (int m = 0; m < 4; ++m) _Pragma("unroll") for (int n = 0; n < 2; ++n) _Pragma("unroll") for (int k = 0; k < 2; ++k) \
        acc[ai][bj][m][n] = __builtin_amdgcn_mfma_f32_16x16x32_bf16(Bt[n][k], At[m][k], acc[ai][bj][m][n], 0, 0, 0); __builtin_amdgcn_s_setprio(0); } while (0)
#define PG8_WAIT_V(n) asm volatile("s_waitcnt vmcnt(" #n ")" ::: "memory")
#define PG8_WAIT_L(n) asm volatile("s_waitcnt lgkmcnt(" #n ")" ::: "memory")
#define PG8_BAR __builtin_amdgcn_s_barrier()
#define PG8_SCHED __builtin_amdgcn_sched_barrier(0)
    Unit cur, nxt; int ui = 0;
    if (!S.next(0, cur)) return;
    f32x4 acc[2][2][4][2];
#pragma unroll
    for (int a = 0; a < 2; ++a)
#pragma unroll
        for (int b = 0; b < 2; ++b)
#pragma unroll
            for (int m = 0; m < 4; ++m)
#pragma unroll
                for (int n = 0; n < 2; ++n) acc[a][b][m][n] = (f32x4){0.f, 0.f, 0.f, 0.f};
    bf16x8 At[4][2], B0[2][2], B1[2][2];
    const char* cA = (const char*)g.A + (size_t)cur.pm * tstepA; const char* cB = (const char*)g.Bt + (size_t)cur.pn * tstepB;
    S.a_ready(cur);
    if constexpr (SP2) {
        PG8_STAGE(PG8_SB(0, 0), cB, voffB); PG8_STAGE(PG8_SB(0, 1), cB + hstepB, voffB); PG8_STAGE(PG8_SA(0, 0), cA, voffA); PG8_STAGE(PG8_SA(0, 1), cA + hstepA, voffA);
        if (wr == 1) PG8_BAR;
        PG8_WAIT_V(2); PG8_BAR;
        PG8_STAGE(PG8_SB(1, 0), cB + kstep, voffB); PG8_STAGE(PG8_SA(1, 0), cA + kstep, voffA); PG8_STAGE(PG8_SB(1, 1), cB + hstepB + kstep, voffB);
        PG8_WAIT_V(6); PG8_BAR;
    } else {
        PG8_STAGE(PG8_SB(0, 0), cB, voffB); PG8_STAGE(PG8_SA(0, 0), cA, voffA); PG8_STAGE(PG8_SB(0, 1), cB + hstepB, voffB); PG8_STAGE(PG8_SA(0, 1), cA + hstepA, voffA);
        if (wr == 1) PG8_BAR;
        PG8_WAIT_V(4); PG8_BAR;
        PG8_STAGE(PG8_SB(1, 0), cB + kstep, voffB); PG8_STAGE(PG8_SA(1, 0), cA + kstep, voffA); PG8_STAGE(PG8_SB(1, 1), cB + hstepB + kstep, voffB);
        PG8_WAIT_V(6); PG8_BAR;
    }
    for (;;) {
        const bool has_next = S.next(ui + 1, nxt);
        const char* nA = has_next ? (const char*)g.A + (size_t)nxt.pm * tstepA : cA; const char* nB = has_next ? (const char*)g.Bt + (size_t)nxt.pn * tstepB : cB;
        for (int t = 0; t < nt; t += 2) {
            const bool last = (t == nt - 2);
            const char* a1 = cA + (size_t)(t + 1) * kstep;
            const char* a2 = last ? nA : cA + (size_t)(t + 2) * kstep; const char* b2 = last ? nB : cB + (size_t)(t + 2) * kstep;
            const char* a3 = a2 + kstep; const char* b3 = b2 + kstep;
            if (last && has_next) S.a_ready(nxt);
            if constexpr (SP2) {
            PG8_LDB(B0, 0, 0); PG8_LDB(B1, 0, 1); PG8_SCHED; PG8_LDA(At, 0, 0); PG8_STAGE(PG8_SA(1, 1), a1 + hstepA, voffA);
            PG8_WAIT_V(8); PG8_WAIT_L(0); PG8_BAR; PG8_MMA(0, 0, At, B0); PG8_MMA(0, 1, At, B1); PG8_BAR; PG8_SCHED;
            PG8_LDA(At, 0, 1); PG8_STAGE(PG8_SB(0, 0), b2, voffB); PG8_STAGE(PG8_SB(0, 1), b2 + hstepB, voffB); PG8_STAGE(PG8_SA(0, 0), a2, voffA);
            PG8_WAIT_V(8); PG8_WAIT_L(0); PG8_BAR; PG8_MMA(1, 0, At, B0); PG8_MMA(1, 1, At, B1); PG8_BAR; PG8_SCHED;
            PG8_LDB(B0, 1, 0); PG8_LDB(B1, 1, 1); PG8_SCHED; PG8_LDA(At, 1, 0); PG8_STAGE(PG8_SA(0, 1), a2 + hstepA, voffA);
            PG8_WAIT_V(8); PG8_WAIT_L(0); PG8_BAR; PG8_MMA(0, 0, At, B0); PG8_MMA(0, 1, At, B1); PG8_BAR; PG8_SCHED;
            PG8_LDA(At, 1, 1); PG8_STAGE(PG8_SB(1, 0), b3, voffB); PG8_STAGE(PG8_SB(1, 1), b3 + hstepB, voffB); PG8_STAGE(PG8_SA(1, 0), a3, voffA);
            PG8_WAIT_V(8); PG8_WAIT_L(0); PG8_BAR; PG8_MMA(1, 0, At, B0); PG8_MMA(1, 1, At, B1); PG8_BAR; PG8_SCHED;
            } else {
            PG8_LDB(B0, 0, 0); PG8_SCHED; PG8_LDA(At, 0, 0); PG8_STAGE(PG8_SA(1, 1), a1 + hstepA, voffA);
            PG8_WAIT_L(8); PG8_BAR; PG8_WAIT_L(0); PG8_MMA(0, 0, At, B0); PG8_BAR; PG8_SCHED;
            PG8_LDB(B1, 0, 1); PG8_STAGE(PG8_SB(0, 0), b2, voffB);
            PG8_BAR; PG8_WAIT_L(0); PG8_MMA(0, 1, At, B1); PG8_BAR;
            PG8_LDA(At, 0, 1); PG8_STAGE(PG8_SA(0, 0), a2, voffA);
            PG8_BAR; PG8_WAIT_L(0); PG8_MMA(1, 0, At, B0); PG8_BAR; PG8_SCHED;
            PG8_STAGE(PG8_SB(0, 1), b2 + hstepB, voffB);
            PG8_WAIT_V(6); PG8_BAR; PG8_MMA(1, 1, At, B1); PG8_BAR;
            PG8_LDB(B0, 1, 0); PG8_SCHED; PG8_LDA(At, 1, 0); PG8_STAGE(PG8_SA(0, 1), a2 + hstepA, voffA);
            PG8_WAIT_L(8); PG8_BAR; PG8_WAIT_L(0); PG8_MMA(0, 0, At, B0); PG8_BAR; PG8_SCHED;
            PG8_LDB(B1, 1, 1); PG8_STAGE(PG8_SB(1, 0), b3, voffB);
            PG8_BAR; PG8_WAIT_L(0); PG8_MMA(0, 1, At, B1); PG8_BAR;
            PG8_LDA(At, 1, 1); PG8_STAGE(PG8_SA(1, 0), a3, voffA);
            PG8_BAR; PG8_WAIT_L(0); PG8_MMA(1, 0, At, B0); PG8_BAR; PG8_SCHED;
            PG8_STAGE(PG8_SB(1, 1), b3 + hstepB, voffB);
            PG8_WAIT_V(6); PG8_BAR; PG8_MMA(1, 1, At, B1); PG8_BAR;
            }
        }
        if constexpr (ALIGN_EPI) { if (wr == 0) PG8_BAR; }
        if constexpr (!Epi::AFTER_DRAIN) { E(acc, cur, wr, wc, fr, fq); S.done(cur); }
        if (!has_next) break;
#pragma unroll
        for (int a = 0; a < 2; ++a)
#pragma unroll
            for (int b = 0; b < 2; ++b)
#pragma unroll
                for (int m = 0; m < 4; ++m)
#pragma unroll
                    for (int n = 0; n < 2; ++n) acc[a][b][m][n] = (f32x4){0.f, 0.f, 0.f, 0.f};
        cur = nxt; cA = nA; cB = nB; ++ui;
        if constexpr (ALIGN_EPI) { if (wr == 1) PG8_BAR; }
    }
    PG8_WAIT_V(0);
    if constexpr (!ALIGN_EPI) { if (wr == 0) PG8_BAR; }
    PG8_BAR;
    if constexpr (Epi::AFTER_DRAIN) { E.fused(acc, cur, wr, wc, fr, fq, lds, wid, lane); S.done(cur); }
#undef PG8_SA
#undef PG8_SB
#undef PG8_STAGE
#undef PG8_LDA
#undef PG8_LDB
#undef PG8_MMA
#undef PG8_WAIT_V
#undef PG8_WAIT_L
#undef PG8_BAR
#undef PG8_SCHED
}
}

namespace {
constexpr int NB = 4, S = 2048, D = 2048, T = NB * S, DEPTH = 2, PLE = 256, DIN = 4192;
constexpr int CONVD = 448, SSMD = 448, NG = 28, NP = 64, DILD = 576, MLAD = 576;
constexpr int OFF_CB = 0, OFF_CC = 448, OFF_CH = 896, OFF_SU = 1344, OFF_DQ = 1792, OFF_DK = 2368, OFF_DV = 2944,
              OFF_CQ = 3520, OFF_CKV = 3904, OFF_KR = 4160;
constexpr int QR = 384, KVR = 256, NQ = 864, NKV = 1152;
constexpr int NE = 64, FF = 512, MT = 320, PSLOT = 36864, NTILE = 128;
constexpr float EPS = 1e-6f;
constexpr int GLU_P = 512;
constexpr int NTHR = 512, NBLK = 256;

typedef unsigned short bf16_t;
__device__ __forceinline__ unsigned f2bf(float f) { unsigned u = __builtin_bit_cast(unsigned, f); return (u + 0x7fffu + ((u >> 16) & 1u)) >> 16; }
typedef __bf16 bf16x2_hw __attribute__((ext_vector_type(2)));
typedef float f32x2_hw __attribute__((ext_vector_type(2)));
__device__ __forceinline__ unsigned pk2(float lo, float hi) { const f32x2_hw v = {lo, hi}; return __builtin_bit_cast(unsigned, __builtin_convertvector(v, bf16x2_hw)); }
__device__ __forceinline__ float shflx(float v, int mask, int lane) { return __builtin_bit_cast(float, __builtin_amdgcn_ds_bpermute((lane ^ mask) << 2, __builtin_bit_cast(int, v))); }
#define GAS __attribute__((address_space(1)))
typedef unsigned u32x4_t __attribute__((ext_vector_type(4)));
typedef unsigned u32x2_t __attribute__((ext_vector_type(2)));
typedef float f32x4_t __attribute__((ext_vector_type(4)));
__device__ __forceinline__ uint4 ldg16(const GAS void* p) { const u32x4_t v = *(const GAS u32x4_t*)p; return make_uint4(v.x, v.y, v.z, v.w); }
__device__ __forceinline__ uint2 ldg8(const GAS void* p) { const u32x2_t v = *(const GAS u32x2_t*)p; return make_uint2(v.x, v.y); }
__device__ __forceinline__ float4 ldgf4(const GAS void* p) { const f32x4_t v = *(const GAS f32x4_t*)p; return make_float4(v.x, v.y, v.z, v.w); }
__device__ __forceinline__ void stg16(GAS void* p, uint4 v) { u32x4_t w; w.x = v.x; w.y = v.y; w.z = v.z; w.w = v.w; *(GAS u32x4_t*)p = w; }
__device__ __forceinline__ void stg8(GAS void* p, uint2 v) { u32x2_t w; w.x = v.x; w.y = v.y; *(GAS u32x2_t*)p = w; }
#define GTID() ((long)bid_ * NTHR + tid_)
#define GSTRIDE() ((long)NBLK * NTHR)


__device__ inline void sincos_d(double a, double& s, double& c) {
    const double k = rint(a * 0.15915494309189535);
    double r = fma(-k, 6.283185307179586, a);
    r = fma(-k, 2.4492935982947064e-16, r);
    const double r2 = r * r;
    double ss = 0.0, cc = 0.0;
#pragma unroll
    for (int n = 14; n >= 1; --n) {
        ss = (ss + 1.0) * (-r2 / (double)((2 * n) * (2 * n + 1)));
        cc = (cc + 1.0) * (-r2 / (double)((2 * n - 1) * (2 * n)));
    }
    s = r * (1.0 + ss);
    c = 1.0 + cc;
}
__device__ __forceinline__ void ph_rope_tab(const int tid_, const int bid_, const int* pos, float* cd, float* sd, float* cm, float* sm) {
    for (long i = GTID(); i < (long)T * 24; i += GSTRIDE()) {
        const int t = (int)(i / 24), j = (int)(i % 24);
        const double LN_THETA = 13.122363377404328;
        double s, c;
        if (j < 8) {
            const double f = exp(-(double)j / 8.0 * LN_THETA);
            sincos_d((double)pos[t] * f, s, c);
            cd[t * 8 + j] = (float)c; sd[t * 8 + j] = (float)s;
        } else {
            const int jj = j - 8;
            const double f = exp(-(double)jj / 16.0 * LN_THETA);
            sincos_d((double)pos[t] * f, s, c);
            cm[t * 16 + jj] = (float)c; sm[t * 16 + jj] = (float)s;
        }
    }
}


__device__ inline float gelu_tanh(float x) {
    const float k = 0.7978845608028654f;
    return 0.5f * x * (1.f + tanhf(k * (x + 0.044715f * x * x * x)));
}


constexpr int SCH = 64, NCH = S / SCH;
struct SsmCoef { float ar, ai; float cr[16], ci[16]; };
__device__ __forceinline__ void ssm_setup(SsmCoef& k, int g, int p, const float* lam_re, const float* lam_im, const float* log_dt, const float* b_re, const float* b_im) {
    const float lr = lam_re[g * NP + p], li = lam_im[g * NP + p];
    const float dt = expf(log_dt[g]);
    const float mag = expf(lr * dt);
    k.ar = mag * cosf(li * dt); k.ai = mag * sinf(li * dt);
    const float nr = k.ar - 1.f, ni = k.ai, den = lr * lr + li * li;
    const float fr = (nr * lr + ni * li) / den, fi = (ni * lr - nr * li) / den;
#pragma unroll
    for (int c4 = 0; c4 < 4; ++c4) {
        const float4 br = *(const float4*)(b_re + (g * NP + p) * 16 + 4 * c4), bi = *(const float4*)(b_im + (g * NP + p) * 16 + 4 * c4);
        k.cr[4 * c4 + 0] = fr * br.x - fi * bi.x; k.ci[4 * c4 + 0] = fr * bi.x + fi * br.x;
        k.cr[4 * c4 + 1] = fr * br.y - fi * bi.y; k.ci[4 * c4 + 1] = fr * bi.y + fi * br.y;
        k.cr[4 * c4 + 2] = fr * br.z - fi * bi.z; k.ci[4 * c4 + 2] = fr * bi.z + fi * br.z;
        k.cr[4 * c4 + 3] = fr * br.w - fi * bi.w; k.ci[4 * c4 + 3] = fr * bi.w + fi * br.w;
    }
}
#define BFLO(w) __builtin_bit_cast(float, (w) << 16)
#define BFHI(w) __builtin_bit_cast(float, (w) & 0xffff0000u)
#define SSM_STEP(up) do { const u32x4_t ua_ = *(const LAS u32x4_t*)(up), ub_ = *(const LAS u32x4_t*)((up) + 16); const uint4 u0_ = make_uint4(ua_.x, ua_.y, ua_.z, ua_.w), u1_ = make_uint4(ub_.x, ub_.y, ub_.z, ub_.w); \
    const float uu_[16] = {BFLO(u0_.x), BFHI(u0_.x), BFLO(u0_.y), BFHI(u0_.y), BFLO(u0_.z), BFHI(u0_.z), BFLO(u0_.w), BFHI(u0_.w), \
                           BFLO(u1_.x), BFHI(u1_.x), BFLO(u1_.y), BFHI(u1_.y), BFLO(u1_.z), BFHI(u1_.z), BFLO(u1_.w), BFHI(u1_.w)}; \
    float sra_[4] = {0.f, 0.f, 0.f, 0.f}, sia_[4] = {0.f, 0.f, 0.f, 0.f}; \
    _Pragma("unroll") for (int c_ = 0; c_ < 16; ++c_) { sra_[c_ & 3] = fmaf(uu_[c_], k.cr[c_], sra_[c_ & 3]); sia_[c_ & 3] = fmaf(uu_[c_], k.ci[c_], sia_[c_ & 3]); } \
    const float sr_ = (sra_[0] + sra_[1]) + (sra_[2] + sra_[3]), si_ = (sia_[0] + sia_[1]) + (sia_[2] + sia_[3]); \
    const float nxr_ = fmaf(k.ar, xr, fmaf(-k.ai, xi, sr_)), nxi_ = fmaf(k.ar, xi, fmaf(k.ai, xr, si_)); xr = nxr_; xi = nxi_; } while (0)

__device__ __forceinline__ void ph_ssm_local(const int tid_, const int bid_, const bf16_t* z_gen, const float* lam_re, const float* lam_im, const float* log_dt,
                                             const float* b_re, const float* b_im, float* E_gen, unsigned char* lds) {
    const GAS bf16_t* z = (const GAS bf16_t*)z_gen;
    GAS float* E = (GAS float*)E_gen;
    const unsigned ul = (unsigned)(size_t)(LAS unsigned char*)lds + (unsigned)(tid_ >> 6) * 2048u;

    const int p = tid_ & 63;
    for (int unit = bid_ * 8 + (tid_ >> 6); unit < NB * NG * NCH; unit += NBLK * 8) {
        const int c = unit % NCH, bg = unit / NCH, g = bg % NG, b = bg / NG;
        SsmCoef k; ssm_setup(k, g, p, lam_re, lam_im, log_dt, b_re, b_im);
        float xr = 0.f, xi = 0.f;
        const GAS bf16_t* zu = z + ((size_t)b * S + (size_t)c * SCH) * DIN + OFF_SU + g * 16;
        {
            const u32x4_t a0 = *(const GAS u32x4_t*)(zu + (size_t)p * DIN), a1 = *(const GAS u32x4_t*)(zu + (size_t)p * DIN + 8);
            *(LAS u32x4_t*)(ul + 32 * p) = a0; *(LAS u32x4_t*)(ul + 32 * p + 16) = a1;
            asm volatile("s_waitcnt lgkmcnt(0)" ::: "memory");
        }
#pragma unroll 8
        for (int t = 0; t < SCH; ++t) SSM_STEP((LAS unsigned char*)(ul + 32 * t));
        asm volatile("s_waitcnt lgkmcnt(0)" ::: "memory");
        GAS float* e = E + ((size_t)bg * NCH + c) * 128;
        e[p] = xr; e[64 + p] = xi;
    }
}
__device__ __forceinline__ void ph_ssm_final(const int tid_, const int bid_, const bf16_t* z_gen, const float* lam_re, const float* lam_im, const float* log_dt,
                                             const float* b_re, const float* b_im, const float* c_re, const float* c_im, const float* dsk, const float* E_gen,
                                             float* gv_gen, bf16_t* gvb_gen, unsigned char* lds) {
    const GAS bf16_t* z = (const GAS bf16_t*)z_gen;
    const GAS float* E = (const GAS float*)E_gen;
    GAS float* gv = (GAS float*)gv_gen;
    GAS bf16_t* gvb = (GAS bf16_t*)gvb_gen;

    typedef float f32x4 __attribute__((ext_vector_type(4)));
    const int p = tid_ & 63, wv = tid_ >> 6, li_ = p & 15, kq = p >> 4;
    float* Xl = (float*)(lds + wv * (16 * 132 * 4));
    const unsigned ul = (unsigned)(size_t)(LAS unsigned char*)lds + 8u * (16 * 132 * 4) + (unsigned)wv * 2048u;
    for (int unit = bid_ * 8 + wv; unit < NB * NG * NCH; unit += NBLK * 8) {
        const int c = unit % NCH, bg = unit / NCH, g = bg % NG, b = bg / NG;
        SsmCoef k; ssm_setup(k, g, p, lam_re, lam_im, log_dt, b_re, b_im);
        float cm[32];
        {
            const float* src = ((kq < 2) ? c_re : c_im) + (size_t)(g * 16 + li_) * NP + 32 * (kq & 1);
            const float sg = (kq < 2) ? 1.f : -1.f;
#pragma unroll
            for (int i = 0; i < 8; ++i) { const float4 v = *(const float4*)(src + 4 * i); cm[4 * i] = sg * v.x; cm[4 * i + 1] = sg * v.y; cm[4 * i + 2] = sg * v.z; cm[4 * i + 3] = sg * v.w; }
        }
        const float dk = dsk[g * 16 + li_];
        float xr = 0.f, xi = 0.f;
        {
            float a64r = k.ar, a64i = k.ai;
#pragma unroll
            for (int i = 0; i < 6; ++i) { const float r2 = a64r * a64r - a64i * a64i, i2 = 2.f * a64r * a64i; a64r = r2; a64i = i2; }
            const GAS float* ep = E + (size_t)bg * NCH * 128;
            for (int cc = 0; cc < c; ++cc) {
                const float er = ep[cc * 128 + p], ei = ep[cc * 128 + 64 + p];
                const float nr = a64r * xr - a64i * xi + er, ni = a64r * xi + a64i * xr + ei;
                xr = nr; xi = ni;
            }
        }
        const size_t t0 = (size_t)b * S + (size_t)c * SCH;
        const GAS bf16_t* zu = z + t0 * DIN + OFF_SU + g * 16;
        {
            const u32x4_t a0 = *(const GAS u32x4_t*)(zu + (size_t)p * DIN), a1 = *(const GAS u32x4_t*)(zu + (size_t)p * DIN + 8);
            *(LAS u32x4_t*)(ul + 32 * p) = a0; *(LAS u32x4_t*)(ul + 32 * p + 16) = a1;
            asm volatile("s_waitcnt lgkmcnt(0)" ::: "memory");
        }
        for (int sb = 0; sb < SCH / 16; ++sb) {
#pragma unroll 8
            for (int tt = 0; tt < 16; ++tt) {
                SSM_STEP((LAS unsigned char*)(ul + 32 * (sb * 16 + tt)));
                Xl[tt * 132 + p] = xr; Xl[tt * 132 + 64 + p] = xi;
            }
            asm volatile("s_waitcnt lgkmcnt(0)" ::: "memory");
            f32x4 af[8];
#pragma unroll
            for (int i = 0; i < 8; ++i) af[i] = *(const f32x4*)(Xl + li_ * 132 + 32 * kq + 4 * i);
            f32x4 acc = (f32x4){0.f, 0.f, 0.f, 0.f};
#pragma unroll
            for (int s2 = 0; s2 < 32; ++s2) acc = __builtin_amdgcn_mfma_f32_16x16x4f32(af[s2 >> 2][s2 & 3], cm[s2], acc, 0, 0, 0);
            asm volatile("s_waitcnt lgkmcnt(0)" ::: "memory");
#pragma unroll
            for (int r = 0; r < 4; ++r) {
                const size_t t = t0 + sb * 16 + 4 * kq + r;
                const float uv = __builtin_bit_cast(float, (unsigned)(*(const LAS bf16_t*)(ul + 32 * (sb * 16 + 4 * kq + r) + 2 * li_)) << 16);
                const float gl = gelu_tanh(acc[r] + dk * uv);
                gv[t * SSMD + g * 16 + li_] = gl;
                gvb[t * GLU_P + g * 16 + li_] = (bf16_t)f2bf(gl);
            }
        }
    }
}

__device__ __forceinline__ void ph_dil_combine(const int tid_, const int bid_, const float* od_gen, const float* lse_gen, bf16_t* mixb_gen) {
    const GAS float* od = (const GAS float*)od_gen;
    const GAS float* lse = (const GAS float*)lse_gen;
    GAS bf16_t* mixb = (GAS bf16_t*)mixb_gen;
    for (long i = GTID(); i < (long)T * (DILD / 8); i += GSTRIDE()) {
        const int t = (int)(i / (DILD / 8)), col = (int)(i % (DILD / 8)) * 8, head = col >> 6, g = head / 3, hg = head % 3;
        const float l0 = lse[(long)t * 9 + hg], l1 = lse[(long)t * 9 + 3 + hg], l2 = lse[(long)t * 9 + 6 + hg];
        const float m = fmaxf(l0, fmaxf(l1, l2));
        const float e0 = expf(l0 - m), e1 = expf(l1 - m), e2 = expf(l2 - m);
        const float eg = (g == 0) ? e0 : (g == 1 ? e1 : e2);
        const float w = eg / (e0 + e1 + e2);
        const float4 v0 = ldgf4((const GAS void*)(od + (long)t * DILD + col)), v1 = ldgf4((const GAS void*)(od + (long)t * DILD + col + 4));
        stg16((GAS void*)(mixb + (long)t * D + 896 + col), make_uint4(pk2(v0.x * w, v0.y * w), pk2(v0.z * w, v0.w * w), pk2(v1.x * w, v1.y * w), pk2(v1.z * w, v1.w * w)));
    }
}


constexpr int DK_ROW = 72, DV_ROW = 68;
constexpr int DK_BYTES = 64 * DK_ROW * 2, DV_BYTES = 64 * DV_ROW * 2;
__device__ __forceinline__ void ph_dil_attn_mfma(const int tid_, const int bid_, const bf16_t* zb_gen, float* od_gen, float* lse_gen, unsigned char* lds) {
    const GAS bf16_t* zb = (const GAS bf16_t*)zb_gen;
    GAS float* od = (GAS float*)od_gen;
    GAS float* lse = (GAS float*)lse_gen;

    typedef short bf16x8 __attribute__((ext_vector_type(8)));
    typedef float f32x4 __attribute__((ext_vector_type(4)));
    const int lane = tid_ & 63, wv = tid_ >> 6, li = lane & 15, lq = lane >> 4;
    const int skey = tid_ >> 3, spart = tid_ & 7;
    for (int idx = bid_; idx < 576; idx += NBLK) {
        const int u = idx & 15, bh = idx >> 4, b = bh / 9, head = bh % 9, g = head / 3;
        const int dil = (g == 0) ? 1 : (g == 1 ? 4 : 16);
        const int i_q = (g == 0) ? u : (g == 1 ? (u & 3) : 0), m_res = (g == 0) ? 0 : (g == 1 ? (u >> 2) : u);
        const int q0 = i_q * 128, qw = q0 + wv * 16;
        const size_t tb = (size_t)b * S + m_res;
        bf16x8 qf[2];
#pragma unroll
        for (int ks = 0; ks < 2; ++ks) qf[ks] = *(const GAS bf16x8*)(zb + (tb + (size_t)(qw + li) * dil) * DIN + OFF_DQ + head * 64 + 32 * ks + 8 * lq);
        f32x4 o[4];
#pragma unroll
        for (int dt = 0; dt < 4; ++dt) o[dt] = (f32x4){0.f, 0.f, 0.f, 0.f};
        float mrun = -1e30f, lrun = 0.f;
        const int kb_lo = (i_q == 0) ? 0 : (2 * i_q - 2), kb_hi = 2 * i_q + 2;
        uint4 rk, rv;
        {
            const size_t tk = tb + (size_t)(kb_lo * 64 + skey) * dil;
            rk = ldg16((const GAS void*)(zb + tk * DIN + OFF_DK + head * 64 + 8 * spart));
            rv = ldg16((const GAS void*)(zb + tk * DIN + OFF_DV + head * 64 + 8 * spart));
        }
        __syncthreads();
        {
            *(uint4*)(lds + (skey * DK_ROW + 8 * spart) * 2) = rk;
            bf16_t* vt = (bf16_t*)(lds + 2 * DK_BYTES);
            const unsigned w[4] = {rv.x, rv.y, rv.z, rv.w};
#pragma unroll
            for (int e = 0; e < 8; ++e) vt[(8 * spart + e) * DV_ROW + skey] = (bf16_t)((w[e >> 1] >> ((e & 1) * 16)) & 0xffffu);
        }
        __syncthreads();
        for (int kb = kb_lo; kb < kb_hi; ++kb) {
            const int k0 = kb * 64, par = (kb - kb_lo) & 1;
            const bool has_next = (kb + 1 < kb_hi);
            if (has_next) {
                const size_t tk = tb + (size_t)(k0 + 64 + skey) * dil;
                rk = ldg16((const GAS void*)(zb + tk * DIN + OFF_DK + head * 64 + 8 * spart));
                rv = ldg16((const GAS void*)(zb + tk * DIN + OFF_DV + head * 64 + 8 * spart));
            }
            if (k0 <= qw + 15 && k0 + 63 >= qw - 128) {
                const unsigned char* kt = lds + par * DK_BYTES;
                const unsigned char* vt = lds + 2 * DK_BYTES + par * DV_BYTES;
                bf16x8 kf[4][2], vf[4][2];
#pragma unroll
                for (int ti = 0; ti < 4; ++ti)
#pragma unroll
                    for (int ks = 0; ks < 2; ++ks) kf[ti][ks] = *(const bf16x8*)(kt + ((16 * ti + li) * DK_ROW + 32 * ks + 8 * lq) * 2);
#pragma unroll
                for (int dt = 0; dt < 4; ++dt)
#pragma unroll
                    for (int s2 = 0; s2 < 2; ++s2) {
                        const unsigned char* vp = vt + ((16 * dt + li) * DV_ROW + 32 * s2 + 4 * lq) * 2;
                        const uint2 lo = *(const uint2*)vp, hi = *(const uint2*)(vp + 32);
                        const uint4 w = make_uint4(lo.x, lo.y, hi.x, hi.y);
                        vf[dt][s2] = __builtin_bit_cast(bf16x8, w);
                    }
                __builtin_amdgcn_sched_barrier(0);
                f32x4 sc[4];
#pragma unroll
                for (int ti = 0; ti < 4; ++ti) {
                    sc[ti] = (f32x4){0.f, 0.f, 0.f, 0.f};
#pragma unroll
                    for (int ks = 0; ks < 2; ++ks) sc[ti] = __builtin_amdgcn_mfma_f32_16x16x32_bf16(kf[ti][ks], qf[ks], sc[ti], 0, 0, 0);
                }
                if (k0 + 63 > qw || k0 < qw + 15 - 128) {
                    const int qpos = qw + li;
#pragma unroll
                    for (int ti = 0; ti < 4; ++ti)
#pragma unroll
                        for (int e = 0; e < 4; ++e) { const int key = k0 + 16 * ti + 4 * lq + e; if (key > qpos || key < qpos - 128) sc[ti][e] = -1e30f; }
                }
                float mx = -1e30f;
#pragma unroll
                for (int ti = 0; ti < 4; ++ti)
#pragma unroll
                    for (int e = 0; e < 4; ++e) mx = fmaxf(mx, sc[ti][e]);
                mx = fmaxf(mx, shflx(mx, 16, lane)); mx = fmaxf(mx, shflx(mx, 32, lane));
                const float mnew = fmaxf(mrun, mx);
                const float alpha = __builtin_amdgcn_exp2f(mrun - mnew);
                float rs = 0.f;
#pragma unroll
                for (int ti = 0; ti < 4; ++ti)
#pragma unroll
                    for (int e = 0; e < 4; ++e) { const float p = (sc[ti][e] > -1e29f) ? __builtin_amdgcn_exp2f(sc[ti][e] - mnew) : 0.f; sc[ti][e] = p; rs += p; }
                rs += shflx(rs, 16, lane); rs += shflx(rs, 32, lane);
                lrun = lrun * alpha + rs; mrun = mnew;
#pragma unroll
                for (int dt = 0; dt < 4; ++dt) o[dt] = o[dt] * alpha;
                bf16x8 pb[2];
#pragma unroll
                for (int s2 = 0; s2 < 2; ++s2) {
                    const uint4 w = make_uint4(pk2(sc[2 * s2][0], sc[2 * s2][1]), pk2(sc[2 * s2][2], sc[2 * s2][3]), pk2(sc[2 * s2 + 1][0], sc[2 * s2 + 1][1]), pk2(sc[2 * s2 + 1][2], sc[2 * s2 + 1][3]));
                    pb[s2] = __builtin_bit_cast(bf16x8, w);
                }
#pragma unroll
                for (int dt = 0; dt < 4; ++dt)
#pragma unroll
                    for (int s2 = 0; s2 < 2; ++s2) o[dt] = __builtin_amdgcn_mfma_f32_16x16x32_bf16(vf[dt][s2], pb[s2], o[dt], 0, 0, 0);
            }
            if (has_next) {
                *(uint4*)(lds + (par ^ 1) * DK_BYTES + (skey * DK_ROW + 8 * spart) * 2) = rk;
                bf16_t* vtw = (bf16_t*)(lds + 2 * DK_BYTES + (par ^ 1) * DV_BYTES);
                const unsigned w[4] = {rv.x, rv.y, rv.z, rv.w};
#pragma unroll
                for (int e = 0; e < 8; ++e) vtw[(8 * spart + e) * DV_ROW + skey] = (bf16_t)((w[e >> 1] >> ((e & 1) * 16)) & 0xffffu);
            }
            __syncthreads();
        }
        const float inv = 1.f / lrun;
        const size_t tq = tb + (size_t)(qw + li) * dil;
        GAS float* op = od + tq * DILD + head * 64 + 4 * lq;
#pragma unroll
        for (int dt = 0; dt < 4; ++dt) *(GAS f32x4*)(op + 16 * dt) = o[dt] * inv;
        if (lq == 0) lse[tq * 9 + head] = (mrun + __builtin_amdgcn_logf(lrun)) * 0.6931471805599453f;
    }
}


constexpr int RCOLS = 80;
__device__ __forceinline__ void ph_router_mfma(const int tid_, const int bid_, const float* h_gen, const float* W2_gen, const float* bg, const float* br,
                                               int* eidx, float* gate, float* rsbuf, int* cnt, unsigned char* lds) {
    const GAS float* h = (const GAS float*)h_gen;

    typedef float f32x4 __attribute__((ext_vector_type(4)));
    const int lane = tid_ & 63, wv = tid_ >> 6, li = lane & 15, lq = lane >> 4, kq8 = wv;
    float* part = (float*)lds;
    float* ssp = (float*)(lds + 8 * 32 * RCOLS * 4);
    const int t0 = bid_ * 32;
    typedef short bf16x8 __attribute__((ext_vector_type(8)));
    const GAS float* hp = h + (size_t)(t0 + li) * D + 256 * kq8 + 8 * lq;
    const GAS bf16_t* wp = (const GAS bf16_t*)W2_gen + (size_t)kq8 * 8 * 5 * 2 * 64 * 8 + lane * 8;
    f32x4 acc[2][5];
#pragma unroll
    for (int tt = 0; tt < 2; ++tt)
#pragma unroll
        for (int nb = 0; nb < 5; ++nb) acc[tt][nb] = (f32x4){0.f, 0.f, 0.f, 0.f};
    float ss[2] = {0.f, 0.f};
#pragma unroll 2
    for (int s = 0; s < 8; ++s) {
        f32x4 a0[2], a1[2];
#pragma unroll
        for (int tt = 0; tt < 2; ++tt) { a0[tt] = *(const GAS f32x4*)(hp + (size_t)(16 * tt) * D + 32 * s); a1[tt] = *(const GAS f32x4*)(hp + (size_t)(16 * tt) * D + 32 * s + 4); }
        bf16x8 bw[5][2];
#pragma unroll
        for (int nb = 0; nb < 5; ++nb)
#pragma unroll
            for (int hl = 0; hl < 2; ++hl) bw[nb][hl] = *(const GAS bf16x8*)(wp + (size_t)((s * 5 + nb) * 2 + hl) * 512);
#pragma unroll
        for (int tt = 0; tt < 2; ++tt) {
            const float av[8] = {a0[tt][0], a0[tt][1], a0[tt][2], a0[tt][3], a1[tt][0], a1[tt][1], a1[tt][2], a1[tt][3]};
            unsigned hi[4], lo[4];
#pragma unroll
            for (int e = 0; e < 4; ++e) {
                const float x0 = av[2 * e], x1 = av[2 * e + 1];
                ss[tt] += x0 * x0 + x1 * x1;
                const unsigned h0 = f2bf(x0), h1 = f2bf(x1);
                hi[e] = h0 | (h1 << 16);
                lo[e] = pk2(x0 - __builtin_bit_cast(float, h0 << 16), x1 - __builtin_bit_cast(float, h1 << 16));
            }
            const uint4 hw = make_uint4(hi[0], hi[1], hi[2], hi[3]), lw = make_uint4(lo[0], lo[1], lo[2], lo[3]);
            const bf16x8 ah = __builtin_bit_cast(bf16x8, hw), al = __builtin_bit_cast(bf16x8, lw);
#pragma unroll
            for (int nb = 0; nb < 5; ++nb) {
                acc[tt][nb] = __builtin_amdgcn_mfma_f32_16x16x32_bf16(ah, bw[nb][0], acc[tt][nb], 0, 0, 0);
                acc[tt][nb] = __builtin_amdgcn_mfma_f32_16x16x32_bf16(al, bw[nb][0], acc[tt][nb], 0, 0, 0);
                acc[tt][nb] = __builtin_amdgcn_mfma_f32_16x16x32_bf16(ah, bw[nb][1], acc[tt][nb], 0, 0, 0);
            }
        }
    }
#pragma unroll
    for (int tt = 0; tt < 2; ++tt) {
        float sv = ss[tt];
        sv += shflx(sv, 16, lane); sv += shflx(sv, 32, lane);
        if (lq == 0) ssp[kq8 * 32 + 16 * tt + li] = sv;
#pragma unroll
        for (int nb = 0; nb < 5; ++nb)
#pragma unroll
            for (int r = 0; r < 4; ++r) part[(kq8 * 32 + 16 * tt + 4 * lq + r) * RCOLS + 16 * nb + li] = acc[tt][nb][r];
    }
    __syncthreads();
    float* lgs = (float*)(lds + 8 * 32 * RCOLS * 4 + 1024);
    for (int i = tid_; i < 32 * RCOLS; i += NTHR) {
        const int tk32 = i / RCOLS, c = i % RCOLS;
        float sst = 0.f, v = 0.f;
#pragma unroll
        for (int kq = 0; kq < 8; ++kq) { sst += ssp[kq * 32 + tk32]; v += part[(kq * 32 + tk32) * RCOLS + c]; }
        const float rs = 1.0f / sqrtf(sst / (float)D + EPS);
        float bias = 0.f;
        if (c < 64) bias = br[c]; else if (c < 72) bias = bg[c - 64];
        lgs[i] = v * rs + bias;
        if (c == 0) rsbuf[bid_ * 32 + tk32] = rs;
    }
    __syncthreads();
    if (tid_ < 32) {
        const int t = bid_ * 32 + tid_;
        const float* lg = lgs + tid_ * RCOLS;
        int gi = 0; float mx = lg[64];
        for (int i = 1; i < 8; ++i) { const float v = lg[64 + i]; if (v > mx) { mx = v; gi = i; } }
        float sum = 0.f;
        for (int i = 0; i < 8; ++i) sum += expf(lg[64 + i] - mx);
        const float gp = 1.f / sum;
        const float* e8 = lg + gi * 8;
        int i1 = 0; float v1 = e8[0];
        for (int i = 1; i < 8; ++i) { const float v = e8[i]; if (v > v1) { v1 = v; i1 = i; } }
        int i2 = 0; float v2 = -INFINITY;
        for (int i = 0; i < 8; ++i) { const float v = e8[i]; if (i != i1 && v > v2) { v2 = v; i2 = i; } }
        const float e2 = expf(v2 - v1);
        const float a1 = 1.f / (1.f + e2), a2 = e2 / (1.f + e2);
        eidx[t * 2] = gi * 8 + i1; eidx[t * 2 + 1] = gi * 8 + i2;
        gate[t * 2] = a1 * gp; gate[t * 2 + 1] = a2 * gp;
        atomicAdd(&cnt[gi * 8 + i1], 1); atomicAdd(&cnt[gi * 8 + i2], 1);
    }
    __syncthreads();
}
__device__ __forceinline__ void ph_moe_scatter(const int tid_, const int bid_, const int* eidx, const float* gate, const int* cnt, int* cursor,
                                               const float* h, const float* rsbuf, const float* gn, bf16_t* Ag, float* slot_gate, int* tok_slot, int* ps, int* lte) {
    if (tid_ == 0) {
        int acc = 0;
        for (int e = 0; e < NE; ++e) { ps[e] = acc; acc += ((cnt[e] + MT - 1) / MT) * MT; }
        ps[NE] = acc;
    }
    __syncthreads();
    for (int i = tid_; i < NTILE; i += NTHR) {
        const int r = i * MT; int e = 0;
        if (r < ps[NE]) { for (int k = 0; k < NE; ++k) if (r >= ps[k] && r < ps[k + 1]) e = k; }
        lte[i] = e;
    }
    if (tid_ == 0) lte[NTILE] = ps[NE] / MT;
    const int lane = tid_ & 63, wv = tid_ >> 6, gw = bid_ * 8 + wv;
    int myslot = 0;
    if (lane < 8) { const int a = gw + NBLK * 8 * lane; const int e = eidx[a]; myslot = ps[e] + atomicAdd(&cursor[e], 1); tok_slot[a] = myslot; slot_gate[myslot] = gate[a]; }
    float4 gq0[4], gq1[4];
#pragma unroll
    for (int jj = 0; jj < 4; ++jj) { const int c = jj * 512 + lane * 8; gq0[jj] = ldgf4((const GAS void*)((const GAS float*)gn + c)); gq1[jj] = ldgf4((const GAS void*)((const GAS float*)gn + c + 4)); }
#pragma unroll 2
    for (int j = 0; j < 8; ++j) {
        const int a = gw + NBLK * 8 * j;
        const int slot = __builtin_amdgcn_readlane(myslot, j);
        const int tok = a >> 1;
        const float rs = rsbuf[tok];
        const GAS float* src = (const GAS float*)h + (size_t)tok * D;
        GAS bf16_t* dst = (GAS bf16_t*)Ag + (size_t)slot * D;
#pragma unroll
        for (int jj = 0; jj < 4; ++jj) {
            const int c = jj * 512 + lane * 8;
            const float4 v0 = ldgf4((const GAS void*)(src + c)), v1 = ldgf4((const GAS void*)(src + c + 4));
            const float4 g0 = gq0[jj], g1 = gq1[jj];
            stg16((GAS void*)(dst + c), make_uint4(pk2(v0.x * rs * g0.x, v0.y * rs * g0.y), pk2(v0.z * rs * g0.z, v0.w * rs * g0.w),
                                                   pk2(v1.x * rs * g1.x, v1.y * rs * g1.y), pk2(v1.z * rs * g1.z, v1.w * rs * g1.w)));
        }
    }
}
__device__ __forceinline__ void ph_moe_combine_norm(const int tid_, const int bid_, float* h_gen, const bf16_t* Yb_gen, const int* tok_slot, const float* g_gen, bf16_t* hnb_gen) {
    GAS float* h = (GAS float*)h_gen; const GAS bf16_t* Yb = (const GAS bf16_t*)Yb_gen; const GAS float* g = (const GAS float*)g_gen; GAS bf16_t* hnb = (GAS bf16_t*)hnb_gen;
    const int lane = tid_ & 63, wv = tid_ >> 6;
    int myslots = 0;
    if (lane < 8) myslots = tok_slot[(bid_ * 8 + wv + NBLK * 8 * (lane >> 1)) * 2 + (lane & 1)];
    float4 gq[8];
#pragma unroll
    for (int j = 0; j < 8; ++j) gq[j] = ldgf4((const GAS void*)(g + (lane + 64 * j) * 4));
#pragma unroll 4
    for (int j = 0; j < 4; ++j) {
        const int t = bid_ * 8 + wv + NBLK * 8 * j;
        const int s0 = __builtin_amdgcn_readlane(myslots, 2 * j), s1 = __builtin_amdgcn_readlane(myslots, 2 * j + 1);
        float4 hv[8]; float ss = 0.f;
#pragma unroll
        for (int j = 0; j < 8; ++j) {
            const int c = (lane + 64 * j) * 4;
            hv[j] = ldgf4((const GAS void*)(h + (size_t)t * D + c));
            const uint2 a = ldg8((const GAS void*)(Yb + (size_t)s0 * D + c)), b = ldg8((const GAS void*)(Yb + (size_t)s1 * D + c));
            hv[j].x += __builtin_bit_cast(float, a.x << 16) + __builtin_bit_cast(float, b.x << 16);
            hv[j].y += __builtin_bit_cast(float, a.x & 0xffff0000u) + __builtin_bit_cast(float, b.x & 0xffff0000u);
            hv[j].z += __builtin_bit_cast(float, a.y << 16) + __builtin_bit_cast(float, b.y << 16);
            hv[j].w += __builtin_bit_cast(float, a.y & 0xffff0000u) + __builtin_bit_cast(float, b.y & 0xffff0000u);
            ss += hv[j].x * hv[j].x + hv[j].y * hv[j].y + hv[j].z * hv[j].z + hv[j].w * hv[j].w;
            { f32x4_t w_; w_.x = hv[j].x; w_.y = hv[j].y; w_.z = hv[j].z; w_.w = hv[j].w; *(GAS f32x4_t*)(h + (size_t)t * D + c) = w_; }
        }
#pragma unroll
        for (int o = 32; o > 0; o >>= 1) ss += shflx(ss, o, lane);
        const float rs = 1.0f / sqrtf(ss * (1.0f / (float)D) + EPS);
#pragma unroll
        for (int j = 0; j < 8; ++j) {
            const int c = (lane + 64 * j) * 4;
            const float4 gv = gq[j];
            stg8((GAS void*)(hnb + (size_t)t * D + c), make_uint2(pk2(hv[j].x * rs * gv.x, hv[j].y * rs * gv.y), pk2(hv[j].z * rs * gv.z, hv[j].w * rs * gv.w)));
        }
    }
}
__device__ __forceinline__ void ph_init_rows(const int tid_, const int bid_, const float* x, const float* g, float* h, bf16_t* hb, float* ss) {
    const int lane = tid_ & 63, wv = tid_ >> 6;
    for (int t = bid_ * 8 + wv; t < T; t += NBLK * 8) {
        float sq = 0.f;
#pragma unroll
        for (int j = 0; j < 8; ++j) {
            const int c = (lane + 64 * j) * 4;
            const float4 v = *(const float4*)(x + (size_t)t * D + c);
            const float4 gv = *(const float4*)(g + c);
            *(float4*)(h + (size_t)t * D + c) = v;
            *(uint2*)(hb + (size_t)t * D + c) = make_uint2(pk2(v.x * gv.x, v.y * gv.y), pk2(v.z * gv.z, v.w * gv.w));
            sq += v.x * v.x + v.y * v.y + v.z * v.z + v.w * v.w;
        }
#pragma unroll
        for (int o = 32; o > 0; o >>= 1) sq += shflx(sq, o, lane);
        if (lane == 0) ss[t] = sq;
    }
}
__device__ __forceinline__ void ph_final_norm(const int tid_, const int bid_, const float* h, const float* ss, const float* g, float* out) {
    for (long i = GTID(); i < (long)T * D / 4; i += GSTRIDE()) {
        const int t = (int)(i / (D / 4)), c = (int)(i % (D / 4)) * 4;
        const float rs = 1.0f / sqrtf(ss[t] * (1.0f / (float)D) + EPS);
        const float4 v = ((const float4*)h)[i]; const float4 gv = *(const float4*)(g + c);
        ((float4*)out)[i] = make_float4(v.x * rs * gv.x, v.y * rs * gv.y, v.z * rs * gv.z, v.w * rs * gv.w);
    }
}

#define EPI_DECODE() unsigned ez_ = 0u; asm volatile("" : "+s"(ez_)); int ew_ = wave_s; asm volatile("" : "+s"(ew_)); \
    const int el_ = (int)__builtin_amdgcn_mbcnt_hi(~0u, __builtin_amdgcn_mbcnt_lo(~0u, ez_)); \
    const int wr = ew_ >> 2, wc = ew_ & 3, fr = el_ & 15, fq = el_ >> 4;

struct EpiPle {
    static constexpr bool PERM = false, AFTER_DRAIN = false;
    float* H; const bf16_t* aux; const float* gnext; bf16_t* hb; float* ssn; int wave_s;
    __device__ __forceinline__ void operator()(const pg8::f32x4 (&acc)[2][2][4][2], const pg8::Unit& u, int, int, int, int) const {
        EPI_DECODE();
        const int row0 = u.pm * 256 + wr * 64 + fr, col0 = u.pn * 256 + wc * 32 + fq * 4;
        pg8::f32x4 gnv[2][2];
#pragma unroll
        for (int bj = 0; bj < 2; ++bj)
#pragma unroll
            for (int n = 0; n < 2; ++n) gnv[bj][n] = *(const GAS pg8::f32x4*)(gnext + col0 + bj * 128 + n * 16);
#pragma unroll
        for (int ai = 0; ai < 2; ++ai)
#pragma unroll
            for (int m = 0; m < 4; ++m) {
                const size_t row = (size_t)(row0 + ai * 128 + m * 16);
                float sq = 0.f;
#pragma unroll
                for (int bj = 0; bj < 2; ++bj)
#pragma unroll
                    for (int n = 0; n < 2; ++n) {
                        const int col = col0 + bj * 128 + n * 16;
                        const pg8::f32x4 v = acc[ai][bj][m][n];
                        GAS pg8::f32x4* p = (GAS pg8::f32x4*)(H + row * D + col);
                        const uint2 ab = ldg8((const GAS void*)(aux + row * D + col));
                        const float a[4] = {__uint_as_float(ab.x << 16), __uint_as_float(ab.x & 0xffff0000u), __uint_as_float(ab.y << 16), __uint_as_float(ab.y & 0xffff0000u)};
                        const pg8::f32x4 gn = gnv[bj][n];
                        pg8::f32x4 o = *p;
#pragma unroll
                        for (int e = 0; e < 4; ++e) { o[e] += a[e] * (1.f / (1.f + __expf(-v[e]))); sq += o[e] * o[e]; }
                        *p = o;
                        stg8((GAS void*)(hb + row * D + col), make_uint2(pk2(o[0] * gn[0], o[1] * gn[1]), pk2(o[2] * gn[2], o[3] * gn[3])));
                    }
                sq += shflx(sq, 16, el_); sq += shflx(sq, 32, el_);
                if (fq == 0) (void)__hip_atomic_fetch_add((GAS float*)ssn + row, sq, __ATOMIC_RELAXED, __HIP_MEMORY_SCOPE_AGENT);
            }
    }
};


struct EpiZ {
    static constexpr bool PERM = true, AFTER_DRAIN = false;
    bf16_t* Z; int ldz; int nvalid; const float* ss; int wave_s;
    __device__ __forceinline__ void operator()(const pg8::f32x4 (&acc)[2][2][4][2], const pg8::Unit& u, int, int, int, int) const {
        EPI_DECODE();
        const int row0 = u.pm * 256 + wr * 64 + fr, col0 = u.pn * 256 + wc * 32 + 8 * fq;
#pragma unroll
        for (int ai = 0; ai < 2; ++ai)
#pragma unroll
            for (int m = 0; m < 4; ++m) {
                const size_t row = (size_t)(row0 + ai * 128 + m * 16);
                const float rs = 1.0f / sqrtf(((const GAS float*)ss)[row] * (1.0f / (float)D) + EPS);
#pragma unroll
                for (int bj = 0; bj < 2; ++bj) {
                    const int col = col0 + bj * 128;
                    if (col < nvalid) {
                        const pg8::f32x4 v0 = acc[ai][bj][m][0] * rs, v1 = acc[ai][bj][m][1] * rs;
                        stg16((GAS void*)(Z + row * ldz + col), make_uint4(pk2(v0[0], v0[1]), pk2(v0[2], v0[3]), pk2(v1[0], v1[1]), pk2(v1[2], v1[3])));
                    }
                }
            }
    }
};
struct EpiB16S {
    static constexpr bool PERM = true, AFTER_DRAIN = false;
    bf16_t* O; int ldo; int nvalid; const float* rsrow; const float* rscol; float cs; int wave_s;
    __device__ __forceinline__ void operator()(const pg8::f32x4 (&acc)[2][2][4][2], const pg8::Unit& u, int, int, int, int) const {
        EPI_DECODE();
        const int row0 = u.pm * 256 + wr * 64 + fr, col0 = u.pn * 256 + wc * 32 + 8 * fq;
#pragma unroll
        for (int bj = 0; bj < 2; ++bj) {
            const int col = col0 + bj * 128;
            if (col < nvalid) {
                pg8::f32x4 c0 = (pg8::f32x4){cs, cs, cs, cs}, c1 = c0;
                if (rscol) { c0 = c0 * *(const GAS pg8::f32x4*)(rscol + col); c1 = c1 * *(const GAS pg8::f32x4*)(rscol + col + 4); }
#pragma unroll
                for (int ai = 0; ai < 2; ++ai)
#pragma unroll
                    for (int m = 0; m < 4; ++m) {
                        const size_t row = (size_t)(row0 + ai * 128 + m * 16);
                        const float rr = rsrow ? ((const GAS float*)rsrow)[row] : 1.f;
                        const pg8::f32x4 v0 = acc[ai][bj][m][0] * c0 * rr, v1 = acc[ai][bj][m][1] * c1 * rr;
                        stg16((GAS void*)(O + row * ldo + col), make_uint4(pk2(v0[0], v0[1]), pk2(v0[2], v0[3]), pk2(v1[0], v1[1]), pk2(v1[2], v1[3])));
                    }
            }
        }
    }
};

__device__ __forceinline__ void unpack8(const uint4 w, float (&f)[8]) {
    f[0] = BFLO(w.x); f[1] = BFHI(w.x); f[2] = BFLO(w.y); f[3] = BFHI(w.y); f[4] = BFLO(w.z); f[5] = BFHI(w.z); f[6] = BFLO(w.w); f[7] = BFHI(w.w);
}
__device__ __forceinline__ uint4 pack8(const float (&f)[8]) { return make_uint4(pk2(f[0], f[1]), pk2(f[2], f[3]), pk2(f[4], f[5]), pk2(f[6], f[7])); }
__device__ __forceinline__ void ph_light(const int tid_, const int bid_, bf16_t* zb_gen, const float* cw_gen, const float* cd_gen, const float* sd_gen, const float* cm_gen, const float* sm_gen,
                                         bf16_t* mixb_gen, float* rsq, float* rskv) {
    GAS bf16_t* zb = (GAS bf16_t*)zb_gen; GAS bf16_t* mixb = (GAS bf16_t*)mixb_gen;
    const GAS float* cw = (const GAS float*)cw_gen; const GAS float* cd = (const GAS float*)cd_gen; const GAS float* sd = (const GAS float*)sd_gen;
    const GAS float* cm = (const GAS float*)cm_gen; const GAS float* sm = (const GAS float*)sm_gen;
    const float QS = 0.125f * 1.4426950408889634f;
    const int lane = tid_ & 63, wv = tid_ >> 6;
    for (int t = bid_ * 8 + wv; t < T; t += NBLK * 8) {
        GAS bf16_t* zr = zb + (size_t)t * DIN;
        const int spos = t % S;
        if (lane < 56) {
            const int c = lane * 8;
            float cb[8], a0[8], b0[8], y[8], w0[8], w1[8], w2[8];
            unpack8(ldg16((const GAS void*)(zr + OFF_CB + c)), cb); unpack8(ldg16((const GAS void*)(zr + OFF_CC + c)), a0); unpack8(ldg16((const GAS void*)(zr + OFF_CH + c)), b0);
#pragma unroll
            for (int e = 0; e < 8; ++e) { w0[e] = cw[c + e]; w1[e] = cw[CONVD + c + e]; w2[e] = cw[2 * CONVD + c + e]; y[e] = w2[e] * a0[e] * b0[e]; }
            if (spos >= 1) { float a1[8], b1[8]; unpack8(ldg16((const GAS void*)(zr - DIN + OFF_CC + c)), a1); unpack8(ldg16((const GAS void*)(zr - DIN + OFF_CH + c)), b1);
#pragma unroll
                for (int e = 0; e < 8; ++e) y[e] += w1[e] * a1[e] * b1[e]; }
            if (spos >= 2) { float a2[8], b2[8]; unpack8(ldg16((const GAS void*)(zr - 2 * DIN + OFF_CC + c)), a2); unpack8(ldg16((const GAS void*)(zr - 2 * DIN + OFF_CH + c)), b2);
#pragma unroll
                for (int e = 0; e < 8; ++e) y[e] += w0[e] * a2[e] * b2[e]; }
#pragma unroll
            for (int e = 0; e < 8; ++e) y[e] *= cb[e];
            stg16((GAS void*)(mixb + (size_t)t * D + c), pack8(y));
        }
        if (lane < 18) {
            const int isk = lane / 9, head = lane % 9;
            GAS bf16_t* p = zr + (isk ? OFF_DK : OFF_DQ) + head * 64;
            float x1[8], x2[8], o1[8], o2[8];
            unpack8(ldg16((const GAS void*)p), x1); unpack8(ldg16((const GAS void*)(p + 8)), x2);
            const float sc = isk ? 1.f : QS;
#pragma unroll
            for (int e = 0; e < 8; ++e) { const float c = cd[t * 8 + e], sn = sd[t * 8 + e]; o1[e] = (x1[e] * c - x2[e] * sn) * sc; o2[e] = (x2[e] * c + x1[e] * sn) * sc; }
            stg16((GAS void*)p, pack8(o1)); stg16((GAS void*)(p + 8), pack8(o2));
        }
        if (lane < 54) {
            const int head = lane / 6, ch = 2 + lane % 6;
            GAS bf16_t* p = zr + OFF_DQ + head * 64 + ch * 8;
            float x[8]; unpack8(ldg16((const GAS void*)p), x);
#pragma unroll
            for (int e = 0; e < 8; ++e) x[e] *= QS;
            stg16((GAS void*)p, pack8(x));
        }
        if (lane < 2) {
            GAS bf16_t* p = zr + OFF_KR + 8 * lane;
            float x1[8], x2[8], o1[8], o2[8];
            unpack8(ldg16((const GAS void*)p), x1); unpack8(ldg16((const GAS void*)(p + 16)), x2);
#pragma unroll
            for (int e = 0; e < 8; ++e) { const float c = cm[t * 16 + 8 * lane + e], sn = sm[t * 16 + 8 * lane + e]; o1[e] = x1[e] * c - x2[e] * sn; o2[e] = x2[e] * c + x1[e] * sn; }
            stg16((GAS void*)p, pack8(o1)); stg16((GAS void*)(p + 16), pack8(o2));
        }
        float sq = 0.f, sk = 0.f;
        if (lane < 48) { float x[8]; unpack8(ldg16((const GAS void*)(zr + OFF_CQ + 8 * lane)), x);
#pragma unroll
            for (int e = 0; e < 8; ++e) sq += x[e] * x[e]; }
        if (lane < 32) { float x[8]; unpack8(ldg16((const GAS void*)(zr + OFF_CKV + 8 * lane)), x);
#pragma unroll
            for (int e = 0; e < 8; ++e) sk += x[e] * x[e]; }
#pragma unroll
        for (int o = 32; o > 0; o >>= 1) { sq += shflx(sq, o, lane); sk += shflx(sk, o, lane); }
        if (lane == 0) { rsq[t] = 1.0f / sqrtf(sq * (1.0f / (float)QR) + EPS); rskv[t] = 1.0f / sqrtf(sk * (1.0f / (float)KVR) + EPS); }
    }
}


constexpr int MG_A_BYTES = MT * 128, MG_B_BYTES = 128 * 128;
constexpr int MG_MF = MT / 64;
template <int MODE>
__device__ __forceinline__ void moe_gemm(const int tid_in, const int bid_, const LAS int* lte, const bf16_t* A, const int, const int,
                                         const float* W0, const float* W1, bf16_t* out, const float* slot_gate, PG8_LAS unsigned char* lds) {
    using namespace pg8;
    typedef unsigned u32x2_ __attribute__((ext_vector_type(2)));
    typedef float f32x2_ __attribute__((ext_vector_type(2)));
    constexpr int NPN = (MODE == 1) ? 8 : 16;
    constexpr int LDW = (MODE == 1) ? FF : D;
    constexpr int lda = (MODE == 1) ? D : FF, K = lda;
    const int tid = tid_in, wid = __builtin_amdgcn_readfirstlane(tid >> 6), lane = tid & 63, wr = wid >> 1, wc = wid & 1, fr = lane & 15, fq = lane >> 4;
    const int ntl = lte[NTILE], nt = K / 64;
    const int arow = tid >> 3, akc = tid & 7;
    const int aoff_w = arow * 128 + ((akc ^ (arow & 7)) << 4);
    const int np = lane;
    const int boff_w0 = (2 * np) * 128 + ((wid ^ ((2 * np) & 7)) << 4), boff_w1 = (2 * np + 1) * 128 + ((wid ^ ((2 * np + 1) & 7)) << 4);
    const int sw0 = ((fq) ^ (fr & 7)) << 4, sw1 = ((4 + fq) ^ (fr & 7)) << 4;
    const int aoff_r = (80 * wr + fr) * 128;
    const int boff_r = (MODE == 1) ? (32 * wc + fr) * 128 : (64 * wc + fr) * 128;
    PG8_LAS unsigned char* ldsB = lds + 2 * MG_A_BYTES;
    const int nunits_p = ((ntl + 7) >> 3) * 8 * NPN;
    for (int q = bid_; q < nunits_p; q += NBLK) {
        const int grp = q / (8 * NPN), rr = q % (8 * NPN), pl = rr >> 3, mt = grp * 8 + (rr & 7);
        if (mt >= ntl) continue;
        const int e = lte[mt];
        const int koff = (mt * 5) & (nt - 1);
        int zq = 0; asm volatile("" : "+v"(zq));
        const bf16_t* Aq = A; const float* W0q = W0; const float* W1q = W1; asm volatile("" : "+s"(Aq), "+s"(W0q), "+s"(W1q));
        const GAS bf16_t* asrc = (const GAS bf16_t*)(Aq + (size_t)(unsigned)(mt * MT + arow + zq) * lda + 8 * akc);
        const GAS float* wsrc;
        if (MODE == 1) wsrc = (const GAS float*)(((np >= 32) ? W1q : W0q) + (size_t)e * D * FF + 64 * pl + 2 * (np & 31) + zq + (size_t)(8 * wid) * LDW);
        else wsrc = (const GAS float*)(W0q + (size_t)e * FF * D + 128 * pl + 2 * np + zq + (size_t)(8 * wid) * LDW);
        f32x4 acc[MG_MF][4];
#pragma unroll
        for (int m = 0; m < MG_MF; ++m)
#pragma unroll
            for (int n = 0; n < 4; ++n) acc[m][n] = (f32x4){0.f, 0.f, 0.f, 0.f};
        u32x4 ra[5]; f32x2_ rb0[8], rb1[8];
#define MG_LOADA(kt) do { const int kk_ = ((kt) + koff) & (nt - 1); \
            _Pragma("unroll") for (int i_ = 0; i_ < 5; ++i_) ra[i_] = *(const GAS u32x4*)(asrc + (size_t)(64 * i_) * lda + kk_ * 64); } while (0)
#define MG_LOADB(rb, kt) do { const int kk_ = ((kt) + koff) & (nt - 1); \
            _Pragma("unroll") for (int i_ = 0; i_ < 8; ++i_) rb[i_] = __builtin_nontemporal_load((const GAS f32x2_*)(wsrc + (size_t)(kk_ * 64 + i_) * LDW)); } while (0)
#define MG_WRITE(rb, st) do { PG8_LAS unsigned char* aw_ = lds + (st) * MG_A_BYTES + aoff_w; PG8_LAS unsigned char* bw_ = ldsB + (st) * MG_B_BYTES; \
            _Pragma("unroll") for (int i_ = 0; i_ < 5; ++i_) *(PG8_LAS u32x4*)(aw_ + i_ * 64 * 128) = ra[i_]; \
            u32x4 w0_, w1_; \
            w0_.x = cvt_pk_bf16(rb[0][0], rb[1][0]); w0_.y = cvt_pk_bf16(rb[2][0], rb[3][0]); w0_.z = cvt_pk_bf16(rb[4][0], rb[5][0]); w0_.w = cvt_pk_bf16(rb[6][0], rb[7][0]); \
            w1_.x = cvt_pk_bf16(rb[0][1], rb[1][1]); w1_.y = cvt_pk_bf16(rb[2][1], rb[3][1]); w1_.z = cvt_pk_bf16(rb[4][1], rb[5][1]); w1_.w = cvt_pk_bf16(rb[6][1], rb[7][1]); \
            *(PG8_LAS u32x4*)(bw_ + boff_w0) = w0_; *(PG8_LAS u32x4*)(bw_ + boff_w1) = w1_; } while (0)
#define MG_RDA(dst, st, m, swk) do { dst = *(const PG8_LAS bf16x8*)(lds + (st) * MG_A_BYTES + aoff_r + (m) * 16 * 128 + swk); } while (0)
#define MG_MM(m, Af) do { __builtin_amdgcn_s_setprio(1); _Pragma("unroll") for (int n = 0; n < 4; ++n) acc[m][n] = __builtin_amdgcn_mfma_f32_16x16x32_bf16(Bf[n], Af, acc[m][n], 0, 0, 0); __builtin_amdgcn_s_setprio(0); } while (0)
#define MG_HALF(st, swk) do { bf16x8 Bf[4], Aa, Ab; \
            _Pragma("unroll") for (int n = 0; n < 4; ++n) { const int ro_ = (MODE == 1) ? ((n & 1) * 16 + (n >> 1) * 64) * 128 : n * 16 * 128; \
                Bf[n] = *(const PG8_LAS bf16x8*)(ldsB + (st) * MG_B_BYTES + boff_r + ro_ + swk); } \
            MG_RDA(Aa, st, 0, swk); MG_RDA(Ab, st, 1, swk); \
            MG_MM(0, Aa); MG_RDA(Aa, st, 2, swk); \
            MG_MM(1, Ab); MG_RDA(Ab, st, 3, swk); \
            MG_MM(2, Aa); MG_RDA(Aa, st, 4, swk); \
            MG_MM(3, Ab); \
            MG_MM(4, Aa); } while (0)
#define MG_COMPUTE(st) do { MG_HALF(st, sw0); MG_HALF(st, sw1); } while (0)
        MG_LOADA(0); MG_LOADB(rb0, 0); MG_LOADB(rb1, 1);
        MG_WRITE(rb0, 0);
        MG_LOADA(1);
        __syncthreads();
        for (int t = 0; t < nt; t += 2) {
            MG_LOADB(rb0, t + 2);
            MG_COMPUTE(0);
            MG_WRITE(rb1, 1);
            MG_LOADA(t + 2);
            __syncthreads();
            MG_LOADB(rb1, t + 3);
            MG_COMPUTE(1);
            MG_WRITE(rb0, 0);
            MG_LOADA(t + 3);
            __syncthreads();
        }
        int ze = 0; asm volatile("" : "+v"(ze));
        bf16_t* outq = out; const float* sgq = slot_gate; asm volatile("" : "+s"(outq), "+s"(sgq));
#pragma unroll
        for (int m = 0; m < MG_MF; ++m) {
            const size_t row = (size_t)(unsigned)(mt * MT + 80 * wr + m * 16 + fr + ze);
            if (MODE == 1) {
#pragma unroll
                for (int n = 0; n < 2; ++n) {
                    const f32x4 g = acc[m][n], up = acc[m][n + 2];
                    float o[4];
#pragma unroll
                    for (int e2 = 0; e2 < 4; ++e2) o[e2] = (g[e2] / (1.f + __expf(-g[e2]))) * up[e2];
                    u32x2_ w2_; w2_.x = pk2(o[0], o[1]); w2_.y = pk2(o[2], o[3]); *(GAS u32x2_*)(outq + row * FF + 64 * pl + 32 * wc + 16 * n + 4 * fq) = w2_;
                }
            } else {
                const float gt = *(const GAS float*)(sgq + row);
#pragma unroll
                for (int n = 0; n < 4; ++n) {
                    const f32x4 v = acc[m][n] * gt;
                    u32x2_ w2_; w2_.x = pk2(v[0], v[1]); w2_.y = pk2(v[2], v[3]); *(GAS u32x2_*)(outq + row * D + 128 * pl + 64 * wc + 16 * n + 4 * fq) = w2_;
                }
            }
        }
    }
#undef MG_LOADA
#undef MG_LOADB
#undef MG_WRITE
#undef MG_COMPUTE
#undef MG_RDA
#undef MG_MM
#undef MG_HALF
}

__device__ __forceinline__ void ph_thin_win(const int tid_, const int bid_, const bf16_t* hb_gen, const bf16_t* WinT_gen, const float* ss, bf16_t* zb_gen, unsigned char* lds) {
    const GAS bf16_t* hb = (const GAS bf16_t*)hb_gen;
    const GAS bf16_t* WinT = (const GAS bf16_t*)WinT_gen;
    GAS bf16_t* zb = (GAS bf16_t*)zb_gen;

    typedef short bf16x8 __attribute__((ext_vector_type(8)));
    typedef float f32x16 __attribute__((ext_vector_type(16)));
    const int lane = tid_ & 63, wv = tid_ >> 6, l31 = lane & 31, hh = lane >> 5;
    float* part = (float*)lds;
    f32x16 acc[3];
#pragma unroll
    for (int nt = 0; nt < 3; ++nt)
#pragma unroll
        for (int e = 0; e < 16; ++e) acc[nt][e] = 0.f;
    const GAS bf16_t* ap = hb + (size_t)(bid_ * 32 + l31) * D + 256 * wv + 8 * hh;
    const GAS bf16_t* bp = WinT + (size_t)(4096 + l31) * D + 256 * wv + 8 * hh;
#pragma unroll 4
    for (int ks = 0; ks < 16; ++ks) {
        const bf16x8 a = *(const GAS bf16x8*)(ap + 16 * ks);
#pragma unroll
        for (int nt = 0; nt < 3; ++nt) {
            const bf16x8 b = *(const GAS bf16x8*)(bp + (size_t)nt * 32 * D + 16 * ks);
            acc[nt] = __builtin_amdgcn_mfma_f32_32x32x16_bf16(a, b, acc[nt], 0, 0, 0);
        }
    }
#pragma unroll
    for (int nt = 0; nt < 3; ++nt)
#pragma unroll
        for (int e = 0; e < 16; ++e) {
            const int row = (e & 3) + 8 * (e >> 2) + 4 * hh;
            part[((wv * 3 + nt) * 32 + row) * 33 + l31] = acc[nt][e];
        }
    __syncthreads();
    {
        const int row = tid_ >> 4, cg = tid_ & 15;
        const size_t grow = (size_t)bid_ * 32 + row;
        const float rs = 1.0f / sqrtf(ss[grow] * (1.0f / (float)D) + EPS);
        float o[6];
#pragma unroll
        for (int c = 0; c < 6; ++c) {
            const int col = 6 * cg + c, nt = col >> 5, j = col & 31;
            float v = 0.f;
#pragma unroll
            for (int w = 0; w < 8; ++w) v += part[((w * 3 + nt) * 32 + row) * 33 + j];
            o[c] = v * rs;
        }
        GAS unsigned* dst = (GAS unsigned*)(zb + grow * DIN + 4096 + 6 * cg);
        dst[0] = pk2(o[0], o[1]); dst[1] = pk2(o[2], o[3]); dst[2] = pk2(o[4], o[5]);
    }
    __syncthreads();
}

struct MoeOrder {
    const LAS int* tile_e; int nunits, npn, c;
    __device__ __forceinline__ bool next(int i, pg8::Unit& u) const {
        const int q = i * NBLK + c; if (q >= nunits) return false;
        const int mt = q / npn, pl = q % npn; u.pm = mt; u.pn = tile_e[mt] * npn + pl; return true;
    }
    __device__ __forceinline__ void a_ready(const pg8::Unit&) const {}
    __device__ __forceinline__ void done(const pg8::Unit&) const {}
};
__device__ __forceinline__ void tr_reg(const float* W, int ldw, int k0, int n0, bf16_t* WT, size_t dstrow0, int Kpad, int lane, const float* gk = nullptr) {
    const int nq = lane >> 3, kc = lane & 7;
    const float* src = W + (size_t)(k0 + 8 * kc) * ldw + n0 + 4 * nq;
    pg8::f32x4 r[8];
#pragma unroll
    for (int i = 0; i < 8; ++i) { r[i] = *(const pg8::f32x4*)(src + (size_t)i * ldw); if (gk) r[i] = r[i] * gk[k0 + 8 * kc + i]; }
#pragma unroll
    for (int j = 0; j < 4; ++j)
        *(uint4*)(WT + (dstrow0 + 4 * nq + j) * Kpad + k0 + 8 * kc) = make_uint4(pk2(r[0][j], r[1][j]), pk2(r[2][j], r[3][j]), pk2(r[4][j], r[5][j]), pk2(r[6][j], r[7][j]));
}

template <int MODE> struct EpiG {
    static constexpr bool PERM = false, AFTER_DRAIN = false;
    float* C; int ldc; int nvalid; const float* aux; int ldaux; const float* bias; bf16_t* Cb; int ldcb; int wave_s;
    __device__ __forceinline__ void operator()(const pg8::f32x4 (&acc)[2][2][4][2], const pg8::Unit& u, int, int, int, int) const {
        EPI_DECODE();
        const int row0 = u.pm * 256 + wr * 64 + fr, col0 = u.pn * 256 + wc * 32 + fq * 4;
#pragma unroll
        for (int ai = 0; ai < 2; ++ai)
#pragma unroll
            for (int m = 0; m < 4; ++m) {
                const size_t row = (size_t)(row0 + ai * 128 + m * 16);
#pragma unroll
                for (int bj = 0; bj < 2; ++bj)
#pragma unroll
                    for (int n = 0; n < 2; ++n) {
                        const int col = col0 + bj * 128 + n * 16;
                        if (col < nvalid) {
                            const pg8::f32x4 v = acc[ai][bj][m][n];
                            if (MODE == 0) { *(GAS pg8::f32x4*)(C + row * ldc + col) = v; }
                            else if (MODE == 5) { stg8((GAS void*)(Cb + row * ldcb + col), make_uint2(pk2(v[0], v[1]), pk2(v[2], v[3]))); }
                            else if (MODE == 1) { GAS pg8::f32x4* p = (GAS pg8::f32x4*)(C + row * ldc + col); *p = *p + v; }
                            else if (MODE == 3) {
                                pg8::f32x4* p = (pg8::f32x4*)(C + row * ldc + col);
                                const pg8::f32x4 a = *(const pg8::f32x4*)(aux + row * ldaux + col);
                                pg8::f32x4 o = *p;
#pragma unroll
                                for (int e = 0; e < 4; ++e) o[e] += a[e] * (1.f / (1.f + __expf(-v[e])));
                                *p = o;
                            } else if (MODE == 4) {
                                const pg8::f32x4 a = *(const GAS pg8::f32x4*)(aux + row * ldaux + col);
                                const pg8::f32x4 b = *(const GAS pg8::f32x4*)(bias + col);
                                float o[4];
#pragma unroll
                                for (int e = 0; e < 4; ++e) o[e] = a[e] * (1.f / (1.f + __expf(-(v[e] + b[e]))));
                                stg8((GAS void*)(Cb + row * ldcb + col), make_uint2(pk2(o[0], o[1]), pk2(o[2], o[3])));
                            }
                        }
                    }
            }
    }
};


constexpr int KNP = 576;
constexpr int AK_ROW = 104, AV_ROW = 72;
constexpr int AK_BYTES = 64 * AK_ROW * 2, AV_BYTES = 64 * AV_ROW * 2;
constexpr int AV2_ROW = 136;
constexpr int AK2_BYTES = 128 * AK_ROW * 2, AV2_BYTES = 64 * AV2_ROW * 2;
__device__ __forceinline__ void ph_mla_attn_mfma(const int tid_, const int bid_, const bf16_t* qfb_gen, const bf16_t* knb_gen, const bf16_t* zb_gen, const bf16_t* vTb_gen, bf16_t* mixb_gen,
                                                 const float* cm, const float* sm, unsigned char* lds) {
    const GAS bf16_t* qfb = (const GAS bf16_t*)qfb_gen;
    const GAS bf16_t* knb = (const GAS bf16_t*)knb_gen;
    const GAS bf16_t* zb = (const GAS bf16_t*)zb_gen;
    const GAS bf16_t* vTb = (const GAS bf16_t*)vTb_gen;
    GAS bf16_t* mixb = (GAS bf16_t*)mixb_gen;

    typedef short bf16x8 __attribute__((ext_vector_type(8)));
    typedef float f32x4 __attribute__((ext_vector_type(4)));
    const int lane = tid_ & 63, wv = tid_ >> 6, li = lane & 15, lq = lane >> 4, kg = wv >> 2, qg = wv & 3;
    float* mrg = (float*)(lds + 2 * AK2_BYTES + 2 * AV2_BYTES);
    for (int r = 0; r < 3; ++r) {
        const int idx = r * NBLK + ((r & 1) ? (NBLK - 1 - bid_) : bid_);
        if (idx >= 576) break;
        const int qb = 15 - idx / 36, bh = idx % 36, b = bh / 9, h = bh % 9;
        const int q0 = qb * 128, qw = q0 + qg * 32;
        const size_t tb = (size_t)b * S;
        bf16x8 qf[2][3];
#pragma unroll
        for (int qt = 0; qt < 2; ++qt) {
#pragma unroll
            for (int ks = 0; ks < 3; ++ks) qf[qt][ks] = *(const GAS bf16x8*)(qfb + (tb + qw + 16 * qt + li) * NQ + h * 96 + 32 * ks + 8 * lq);
            {
                const uint4 w = __builtin_bit_cast(uint4, qf[qt][2]);
                float f[8], pr[8], o8[8];
                unpack8(w, f);
#pragma unroll
                for (int e = 0; e < 8; ++e) pr[e] = shflx(f[e], 32, lane);
                const size_t tq_ = tb + qw + 16 * qt + li;
                const float4 c0 = *(const float4*)(cm + tq_ * 16 + 8 * (lq & 1)), c1 = *(const float4*)(cm + tq_ * 16 + 8 * (lq & 1) + 4);
                const float4 s0 = *(const float4*)(sm + tq_ * 16 + 8 * (lq & 1)), s1 = *(const float4*)(sm + tq_ * 16 + 8 * (lq & 1) + 4);
                const float cc[8] = {c0.x, c0.y, c0.z, c0.w, c1.x, c1.y, c1.z, c1.w}, sn[8] = {s0.x, s0.y, s0.z, s0.w, s1.x, s1.y, s1.z, s1.w};
                const float sg = (lq < 2) ? -1.f : 1.f;
#pragma unroll
                for (int e = 0; e < 8; ++e) o8[e] = f[e] * cc[e] + sg * pr[e] * sn[e];
                const uint4 wo = pack8(o8);
                qf[qt][2] = __builtin_bit_cast(bf16x8, wo);
            }
        }
        f32x4 o[2][4];
#pragma unroll
        for (int qt = 0; qt < 2; ++qt)
#pragma unroll
            for (int dt = 0; dt < 4; ++dt) o[qt][dt] = (f32x4){0.f, 0.f, 0.f, 0.f};
        float mrun[2] = {-1e30f, -1e30f}, lrun[2] = {0.f, 0.f};
        const int npair = qb + 1;
        uint4 rk[3], rv[2];
#define MLA_LOAD(pr_) do { const size_t t0_ = tb + (size_t)(pr_) * 128; \
            _Pragma("unroll") for (int j_ = 0; j_ < 3; ++j_) { const int c_ = tid_ + 512 * j_, key_ = c_ / 12, part_ = c_ - 12 * key_; \
                rk[j_] = (part_ < 8) ? ldg16((const GAS void*)(knb + (t0_ + key_) * KNP + h * 64 + 8 * part_)) : ldg16((const GAS void*)(zb + (t0_ + key_) * DIN + OFF_KR + 8 * (part_ - 8))); } \
            _Pragma("unroll") for (int j_ = 0; j_ < 2; ++j_) rv[j_] = ldg16((const GAS void*)(vTb + (size_t)(h * 64 + (tid_ >> 4) + 32 * j_) * T + t0_ + 8 * (tid_ & 15))); } while (0)
#define MLA_WRITE(buf) do { unsigned char* kb_ = lds + (buf) * AK2_BYTES; unsigned char* vb_ = lds + 2 * AK2_BYTES + (buf) * AV2_BYTES; \
            _Pragma("unroll") for (int j_ = 0; j_ < 3; ++j_) { const int c_ = tid_ + 512 * j_, key_ = c_ / 12, part_ = c_ - 12 * key_; *(uint4*)(kb_ + (key_ * AK_ROW + 8 * part_) * 2) = rk[j_]; } \
            _Pragma("unroll") for (int j_ = 0; j_ < 2; ++j_) *(uint4*)(vb_ + (((tid_ >> 4) + 32 * j_) * AV2_ROW + 8 * (tid_ & 15)) * 2) = rv[j_]; } while (0)
        MLA_LOAD(0);
        __syncthreads();
        MLA_WRITE(0);
        __syncthreads();
        for (int pr = 0; pr < npair; ++pr) {
            { const int nb_ = (pr + 1 < npair) ? (pr + 1) : pr; MLA_LOAD(nb_); }
            const int k0 = pr * 128 + kg * 64;
            if (k0 <= qw + 31) {
                const unsigned char* kt = lds + (pr & 1) * AK2_BYTES + kg * (64 * AK_ROW * 2);
                const unsigned char* vt = lds + 2 * AK2_BYTES + (pr & 1) * AV2_BYTES + kg * 128;
                bf16x8 kf[4][3];
#pragma unroll
                for (int ti = 0; ti < 4; ++ti)
#pragma unroll
                    for (int ks = 0; ks < 3; ++ks) kf[ti][ks] = *(const bf16x8*)(kt + ((16 * ti + li) * AK_ROW + 32 * ks + 8 * lq) * 2);
                f32x4 sc[2][4];
#pragma unroll
                for (int qt = 0; qt < 2; ++qt)
#pragma unroll
                    for (int ti = 0; ti < 4; ++ti) {
                        sc[qt][ti] = (f32x4){0.f, 0.f, 0.f, 0.f};
#pragma unroll
                        for (int ks = 0; ks < 3; ++ks) sc[qt][ti] = __builtin_amdgcn_mfma_f32_16x16x32_bf16(kf[ti][ks], qf[qt][ks], sc[qt][ti], 0, 0, 0);
                    }
                bf16x8 vf[4][2];
#pragma unroll
                for (int dt = 0; dt < 4; ++dt)
#pragma unroll
                    for (int s2 = 0; s2 < 2; ++s2) {
                        const unsigned char* vp = vt + ((16 * dt + li) * AV2_ROW + 32 * s2 + 4 * lq) * 2;
                        const uint2 lo = *(const uint2*)vp, hi = *(const uint2*)(vp + 32);
                        const uint4 w = make_uint4(lo.x, lo.y, hi.x, hi.y);
                        vf[dt][s2] = __builtin_bit_cast(bf16x8, w);
                    }
#pragma unroll
                for (int qt = 0; qt < 2; ++qt) {
                    const int qs = qw + 16 * qt;
                    if (k0 <= qs + 15) {
                        if (k0 + 63 > qs) {
                            const int qpos = qs + li;
#pragma unroll
                            for (int ti = 0; ti < 4; ++ti)
#pragma unroll
                                for (int e = 0; e < 4; ++e) if (k0 + 16 * ti + 4 * lq + e > qpos) sc[qt][ti][e] = -1e30f;
                        }
                        float mx = -1e30f;
#pragma unroll
                        for (int ti = 0; ti < 4; ++ti)
#pragma unroll
                            for (int e = 0; e < 4; ++e) mx = fmaxf(mx, sc[qt][ti][e]);
                        mx = fmaxf(mx, shflx(mx, 16, lane)); mx = fmaxf(mx, shflx(mx, 32, lane));
                        const float mnew = fmaxf(mrun[qt], mx);
                        const float alpha = __builtin_amdgcn_exp2f(mrun[qt] - mnew);
                        float rs = 0.f;
#pragma unroll
                        for (int ti = 0; ti < 4; ++ti)
#pragma unroll
                            for (int e = 0; e < 4; ++e) { const float p = __builtin_amdgcn_exp2f(sc[qt][ti][e] - mnew); sc[qt][ti][e] = p; rs += p; }
                        rs += shflx(rs, 16, lane); rs += shflx(rs, 32, lane);
                        lrun[qt] = lrun[qt] * alpha + rs; mrun[qt] = mnew;
#pragma unroll
                        for (int dt = 0; dt < 4; ++dt) o[qt][dt] = o[qt][dt] * alpha;
                        bf16x8 pb[2];
#pragma unroll
                        for (int s2 = 0; s2 < 2; ++s2) {
                            const unsigned w0 = pk2(sc[qt][2 * s2][0], sc[qt][2 * s2][1]), w1 = pk2(sc[qt][2 * s2][2], sc[qt][2 * s2][3]);
                            const unsigned w2 = pk2(sc[qt][2 * s2 + 1][0], sc[qt][2 * s2 + 1][1]), w3 = pk2(sc[qt][2 * s2 + 1][2], sc[qt][2 * s2 + 1][3]);
                            const uint4 w = make_uint4(w0, w1, w2, w3);
                            pb[s2] = __builtin_bit_cast(bf16x8, w);
                        }
#pragma unroll
                        for (int dt = 0; dt < 4; ++dt)
#pragma unroll
                            for (int s2 = 0; s2 < 2; ++s2) o[qt][dt] = __builtin_amdgcn_mfma_f32_16x16x32_bf16(vf[dt][s2], pb[s2], o[qt][dt], 0, 0, 0);
                    }
                }
            }
            MLA_WRITE((pr + 1) & 1);
            __syncthreads();
        }
#undef MLA_LOAD
#undef MLA_WRITE
        if (kg == 1) {
#pragma unroll
            for (int qt = 0; qt < 2; ++qt) {
                float* mp = mrg + ((qg * 2 + qt) * 18) * 64 + lane;
                mp[0] = mrun[qt]; mp[64] = lrun[qt];
#pragma unroll
                for (int dt = 0; dt < 4; ++dt)
#pragma unroll
                    for (int e = 0; e < 4; ++e) mp[(2 + 4 * dt + e) * 64] = o[qt][dt][e];
            }
        }
        __syncthreads();
        if (kg == 0) {
#pragma unroll
            for (int qt = 0; qt < 2; ++qt) {
                const float* mp = mrg + ((qg * 2 + qt) * 18) * 64 + lane;
                const float m1 = mp[0], l1 = mp[64];
                const float m = fmaxf(mrun[qt], m1);
                const float a0 = __builtin_amdgcn_exp2f(mrun[qt] - m), a1 = __builtin_amdgcn_exp2f(m1 - m);
                const float inv = 1.f / (lrun[qt] * a0 + l1 * a1);
                GAS bf16_t* op = mixb + (tb + qw + 16 * qt + li) * D + 1472 + h * 64 + 4 * lq;
#pragma unroll
                for (int dt = 0; dt < 4; ++dt) {
                    float v[4];
#pragma unroll
                    for (int e = 0; e < 4; ++e) v[e] = (o[qt][dt][e] * a0 + mp[(2 + 4 * dt + e) * 64] * a1) * inv;
                    stg8((GAS void*)(op + 16 * dt), make_uint2(pk2(v[0], v[1]), pk2(v[2], v[3])));
                }
            }
        }
    }
}


struct Params {
    const float* in[33];
    float* out;
    unsigned char* ws;
};
constexpr int NIN_P = 4352, NQ_P = 1024, NKV_P = 1280;
constexpr size_t al256(size_t x) { return (x + 255) & ~(size_t)255; }
constexpr size_t WS_BAR = 0;
constexpr size_t WS_H = al256(WS_BAR + XCD_BAR_WORDS * 4);
constexpr size_t WS_HN = WS_H + (size_t)T * D * 4;
constexpr size_t WS_Z = WS_HN + (size_t)T * D * 4;
constexpr size_t WS_QM = WS_Z + (size_t)T * DIN * 4;
constexpr size_t WS_KVM = WS_QM + (size_t)T * NQ * 4;
constexpr size_t WS_QF = WS_KVM + (size_t)T * NKV * 4;
constexpr size_t WS_KRF = WS_QF + (size_t)T * NQ * 4;
constexpr size_t WS_QD = WS_KRF + (size_t)T * 32 * 4;
constexpr size_t WS_KD = WS_QD + (size_t)T * DILD * 4;
constexpr size_t WS_OD = WS_KD + (size_t)T * DILD * 4;
constexpr size_t WS_LSE = WS_OD + (size_t)T * DILD * 4;
constexpr size_t WS_X = al256(WS_LSE + (size_t)T * 9 * 4);
constexpr size_t WS_CI = WS_X + (size_t)NB * NG * NCH * 128 * 4;
constexpr size_t WS_GV = WS_CI + (size_t)NB * NG * NCH * 128 * 4;
constexpr size_t WS_CD = WS_GV + (size_t)T * SSMD * 4;
constexpr size_t WS_SD = WS_CD + (size_t)T * 8 * 4;
constexpr size_t WS_CM = WS_SD + (size_t)T * 8 * 4;
constexpr size_t WS_SM = WS_CM + (size_t)T * 16 * 4;
constexpr size_t WS_PPROJ = WS_SM + (size_t)T * 16 * 4;
constexpr size_t WS_EIDX = WS_PPROJ + (size_t)T * D * 4;
constexpr size_t WS_GATE = WS_EIDX + (size_t)T * 2 * 4;
constexpr size_t WS_CNT = WS_GATE + (size_t)T * 2 * 4;
constexpr size_t WS_CURSOR = WS_CNT + 256;
constexpr size_t WS_PSTART = WS_CURSOR + 256;
constexpr size_t WS_TILEE = WS_PSTART + 512;
constexpr size_t WS_SLOTGATE = al256(WS_TILEE + (NTILE + 1) * 4);
constexpr size_t WS_TOKSLOT = WS_SLOTGATE + (size_t)PSLOT * 4;
constexpr size_t WS_AG = WS_TOKSLOT + (size_t)T * 2 * 4;
constexpr size_t WS_ACTB = WS_AG + (size_t)PSLOT * D * 2;
constexpr size_t WS_YB = WS_ACTB + (size_t)PSLOT * FF * 2;
constexpr size_t WS_W1T = WS_YB + (size_t)PSLOT * D * 2;
constexpr size_t WS_W2T = WS_W1T + (size_t)NE * 2 * FF * D * 2;
constexpr size_t WS_HNB = WS_W2T + (size_t)NE * D * FF * 2;
constexpr size_t WS_MIXB = WS_HNB + (size_t)T * D * 2;
constexpr size_t WS_NQB = WS_MIXB + (size_t)T * D * 2;
constexpr size_t WS_NKVB = WS_NQB + (size_t)T * QR * 2;
constexpr size_t WS_GVB = WS_NKVB + (size_t)T * KVR * 2;
constexpr size_t WS_PB = WS_GVB + (size_t)T * GLU_P * 2;
constexpr size_t WS_WIN = WS_PB + (size_t)DEPTH * T * PLE * 2;
constexpr size_t WS_WOUT = WS_WIN + (size_t)DEPTH * NIN_P * D * 2;
constexpr size_t WS_WPG = WS_WOUT + (size_t)DEPTH * D * D * 2;
constexpr size_t WS_WPP = WS_WPG + (size_t)DEPTH * D * D * 2;
constexpr size_t WS_WUQ = WS_WPP + (size_t)DEPTH * D * PLE * 2;
constexpr size_t WS_WUKV = WS_WUQ + (size_t)DEPTH * NQ_P * QR * 2;
constexpr size_t WS_WGLU = WS_WUKV + (size_t)DEPTH * NKV_P * KVR * 2;
constexpr size_t WS_WKT = WS_WGLU + (size_t)DEPTH * GLU_P * GLU_P * 2;
constexpr size_t WS_WVT = WS_WKT + (size_t)DEPTH * 768 * KVR * 2;
constexpr size_t WS_QFB = WS_WVT + (size_t)DEPTH * 768 * KVR * 2;
constexpr size_t WS_KNB = WS_QFB + (size_t)T * NQ * 2;
constexpr size_t WS_KRB = WS_KNB + (size_t)T * KNP * 2;
constexpr size_t WS_VTB = WS_KRB + (size_t)T * 32 * 2;
constexpr size_t WS_W2R = WS_VTB + (size_t)768 * T * 2;
constexpr size_t WS_RSBUF = WS_W2R + (size_t)DEPTH * D * RCOLS * 4;
constexpr size_t WS_SS = WS_RSBUF + (size_t)T * 4;
constexpr size_t WS_RSQ = WS_SS + (size_t)3 * T * 4;
constexpr size_t WS_RSKV = WS_RSQ + (size_t)T * 4;
constexpr size_t WS_HB = WS_RSKV + (size_t)T * 4;
constexpr size_t WS_DQB = WS_HB + (size_t)T * D * 2;
constexpr size_t WS_DKB = WS_DQB + (size_t)T * DILD * 2;
constexpr size_t WS_DVB = WS_DKB + (size_t)T * DILD * 2;
constexpr size_t WS_END = WS_DVB + (size_t)T * DILD * 2;

constexpr int LDS_SCR = 0;
constexpr int LDS_XB = 131072;
constexpr int LDS_INP = LDS_XB + 16;
constexpr int LDS_LG = LDS_INP + 288;
constexpr int LDS_PS = LDS_LG + 2304;
constexpr int LDS_TILEE = LDS_PS + 272;
constexpr int LDS_BYTES = 147456;

__global__ void __launch_bounds__(NTHR, 2) mega(Params P) {
    extern __shared__ __attribute__((aligned(16))) unsigned char smem[];
    uint4* xb_words = (uint4*)(smem + LDS_XB);
    unsigned long long* inp = (unsigned long long*)(smem + LDS_INP);
    float (*As)[132] = (float (*)[132])(smem + LDS_SCR);
    float (*Bs)[68] = (float (*)[68])(smem + LDS_SCR + 16 * 132 * 4);
    float (*lg)[72] = (float (*)[72])(smem + LDS_LG);
    int* ps = (int*)(smem + LDS_PS);
    if (threadIdx.x == 0) {
        *xb_words = make_uint4(0u, 0u, 0u, 0u);
#pragma unroll
        for (int i = 0; i < 33; ++i) inp[i] = (unsigned long long)P.in[i];
        inp[33] = (unsigned long long)P.out;
        inp[34] = (unsigned long long)P.ws;
    }
    __syncthreads();
    const unsigned smem_base = (unsigned)(size_t)(LAS unsigned char*)smem;
#define LDP(i) ({ unsigned b_ = smem_base; asm volatile("" : "+s"(b_)); const unsigned long long v_ = *(LAS unsigned long long*)(b_ + LDS_INP + 8 * (i)); \
        ((unsigned long long)(unsigned)__builtin_amdgcn_readfirstlane((int)(unsigned)v_) | ((unsigned long long)(unsigned)__builtin_amdgcn_readfirstlane((int)(unsigned)(v_ >> 32)) << 32)); })
#define INP(i) ((const float*)LDP(i))
#define WSF(off) ((float*)(LDP(34) + (off)))
#define WSI(off) ((int*)(LDP(34) + (off)))
#define WSB(off) ((bf16_t*)(LDP(34) + (off)))
#define LAUNDER() unsigned z_ = 0u; asm volatile("" : "+s"(z_)); int ws_ = wave_s; asm volatile("" : "+s"(ws_)); int tid_ = (ws_ << 6) | (int)__builtin_amdgcn_mbcnt_hi(~0u, __builtin_amdgcn_mbcnt_lo(~0u, z_)); asm volatile("" : "+v"(tid_)); int bid_ = blockIdx.x; asm volatile("" : "+s"(bid_));
    const int wave_s = __builtin_amdgcn_readfirstlane((int)(threadIdx.x >> 6));
    XcdBarrier bar = xcd_barrier_post((unsigned*)(P.ws + WS_BAR), (volatile LAS unsigned*)(smem + LDS_XB), (int)threadIdx.x);
#define BAR() do { LAUNDER(); XcdBarrier b_; b_.bar = (unsigned*)(LDP(34) + WS_BAR); unsigned bx_ = bar.x; asm volatile("" : "+s"(bx_)); b_.x = bx_; b_.st = bar.st; xcd_barrier(b_, tid_); } while (0)
#define PG8_RUN(MODE, Aptr, Bptr, Mv, Nv, Kv, ldav, ldbv, EPI_INIT) do { LAUNDER(); \
        pg8::Gemm g_{(const bf16_t*)(Aptr), (const bf16_t*)(Bptr), (Mv), (Nv), (Kv), (ldav), (ldbv)}; \
        pg8::StaticOrder S_; S_.init((Mv), (Nv), NBLK, bid_); \
        EpiG<MODE> E_ EPI_INIT; \
        pg8::gemm_phase<EpiG<MODE>, pg8::StaticOrder, true, true>(tid_, (PG8_LAS unsigned char*)(smem + LDS_SCR), g_, S_, E_); } while (0)

    {
        LAUNDER();
        const float* x = INP(0);
        ph_init_rows(tid_, bid_, x, INP(3), WSF(WS_H), WSB(WS_HB), WSF(WS_SS));
        for (long i = GTID(); i < (long)2 * T; i += GSTRIDE()) WSF(WS_SS)[T + i] = 0.f;
        const float* pp = INP(1);
        for (long i = GTID(); i < (long)DEPTH * T * PLE / 2; i += GSTRIDE()) { const float2 v = ((const float2*)pp)[i]; ((unsigned*)WSB(WS_PB))[i] = pk2(v.x, v.y); }
        for (long i = GTID(); i < (long)T * 64; i += GSTRIDE()) WSB(WS_GVB)[(i >> 6) * GLU_P + 448 + (i & 63)] = 0;
    }
    { LAUNDER(); ph_rope_tab(tid_, bid_, (const int*)INP(2), WSF(WS_CD), WSF(WS_SD), WSF(WS_CM), WSF(WS_SM)); }
    {
        LAUNDER();
        for (long i = GTID(); i < (long)DEPTH * D * RCOLS; i += GSTRIDE()) {
            const int Lw = (int)(i / (D * RCOLS)); int r = (int)(i % (D * RCOLS));
            const int j = r & 7; r >>= 3; const int jc = r & 15; r >>= 4; const int q = r & 3; r >>= 2; const int nb = r % 5; r /= 5; const int sst = r & 15, kq4 = r >> 4;
            const int k = 512 * kq4 + 32 * sst + 8 * q + j, col = 16 * nb + jc;
            float v = 0.f;
            if (col < 64) v = INP(24)[(size_t)Lw * D * NE + (size_t)k * NE + col];
            else if (col < 72) v = INP(22)[(size_t)Lw * D * 8 + (size_t)k * 8 + (col - 64)];
            v *= INP(21)[(size_t)Lw * D + k];
            const unsigned hb_ = f2bf(v);
            const unsigned lb_ = f2bf(v - __builtin_bit_cast(float, hb_ << 16));
            bf16_t* dst = (bf16_t*)WSF(WS_W2R) + (size_t)Lw * D * RCOLS * 2;
            const size_t base = ((size_t)((kq4 * 16 + sst) * 5 + nb) * 2) * 512 + (size_t)(16 * q + jc) * 8 + j;
            dst[base] = (bf16_t)hb_; dst[base + 512] = (bf16_t)lb_;
        }
    }
    {
        LAUNDER();
        const int wave = tid_ >> 6, lane = tid_ & 63;
        const int gw = bid_ * 8 + wave, NGW = NBLK * 8;
        constexpr int I_IN = (D / 64) * (DIN / 32), I_OUT = (D / 64) * (D / 32), I_PG = I_OUT, I_PP = (PLE / 64) * (D / 32),
                      I_UQ = (QR / 64) * (NQ / 32), I_GLU = (SSMD / 64) * (SSMD / 32);
        constexpr int I_LAYER = I_IN + I_OUT + I_PG + I_PP + I_UQ + I_GLU;
        for (int it = gw; it < DEPTH * I_LAYER; it += NGW) {
            const int L = it / I_LAYER; int r = it % I_LAYER;
            if (r < I_IN) { const int nbk = DIN / 32; tr_reg(INP(4) + (size_t)L * D * DIN, DIN, 64 * (r / nbk), 32 * (r % nbk), WSB(WS_WIN) + (size_t)L * NIN_P * D, 32 * (r % nbk), D, lane); continue; } r -= I_IN;
            if (r < I_OUT) { const int nbk = D / 32; tr_reg(INP(20) + (size_t)L * D * D, D, 64 * (r / nbk), 32 * (r % nbk), WSB(WS_WOUT) + (size_t)L * D * D, 32 * (r % nbk), D, lane); continue; } r -= I_OUT;
            if (r < I_PG) { const int nbk = D / 32; tr_reg(INP(31) + (size_t)L * D * D, D, 64 * (r / nbk), 32 * (r % nbk), WSB(WS_WPG) + (size_t)L * D * D, 32 * (r % nbk), D, lane); continue; } r -= I_PG;
            if (r < I_PP) { const int nbk = D / 32; tr_reg(INP(30) + (size_t)L * PLE * D, D, 64 * (r / nbk), 32 * (r % nbk), WSB(WS_WPP) + (size_t)L * D * PLE, 32 * (r % nbk), PLE, lane); continue; } r -= I_PP;
            if (r < I_UQ) { const int nbk = NQ / 32; tr_reg(INP(17) + (size_t)L * QR * NQ, NQ, 64 * (r / nbk), 32 * (r % nbk), WSB(WS_WUQ) + (size_t)L * NQ_P * QR, 32 * (r % nbk), QR, lane, INP(16) + (size_t)L * QR); continue; } r -= I_UQ;
            { const int nbk = SSMD / 32; tr_reg(INP(14) + (size_t)L * SSMD * SSMD, SSMD, 64 * (r / nbk), 32 * (r % nbk), WSB(WS_WGLU) + (size_t)L * GLU_P * GLU_P, 32 * (r % nbk), GLU_P, lane); }
        }
        for (int it = gw; it < DEPTH * 2 * 4 * 18; it += NGW) {
            const int L = it / 144, r = it % 144, sel = r / 72, kb = (r % 72) / 18, nbp = r % 18, h = nbp >> 1, d0 = (nbp & 1) * 32;
            tr_reg(INP(19) + (size_t)L * KVR * NKV, NKV, 64 * kb, h * 128 + sel * 64 + d0, WSB(sel ? WS_WVT : WS_WKT) + (size_t)L * 768 * KVR, 32 * nbp, KVR, lane, INP(18) + (size_t)L * KVR);
        }
        for (long i = GTID(); i < (long)DEPTH * 2 * 192 * KVR / 8; i += GSTRIDE()) {
            const int per = 192 * KVR / 8; const int m = (int)(i / per), w = (int)(i % per);
            *(uint4*)(WSB(WS_WKT) + (size_t)m * 768 * KVR + (size_t)576 * KVR + (size_t)w * 8) = make_uint4(0, 0, 0, 0);
        }
    }
    BAR();
    for (int L0 = 0; L0 < DEPTH; ++L0) {
#define L ({ int l_ = L0; asm volatile("" : "+s"(l_)); l_; })
        { LAUNDER(); if (bid_ == 0 && tid_ < NE) { WSI(WS_CNT)[tid_] = 0; WSI(WS_CURSOR)[tid_] = 0; } }
        {
            LAUNDER();
            pg8::Gemm g_{WSB(WS_HB), WSB(WS_WIN) + (size_t)L * NIN_P * D, T, 4096, D, D, D};
            pg8::StaticOrder S_; S_.init(T, 4096, NBLK, bid_);
            EpiZ E_{WSB(WS_Z), DIN, 4096, WSF(WS_SS) + (size_t)L * T, wave_s};
            pg8::gemm_phase<EpiZ, pg8::StaticOrder, true, true>(tid_, (PG8_LAS unsigned char*)(smem + LDS_SCR), g_, S_, E_);
        }
        { LAUNDER(); ph_thin_win(tid_, bid_, WSB(WS_HB), WSB(WS_WIN) + (size_t)L * NIN_P * D, WSF(WS_SS) + (size_t)L * T, WSB(WS_Z), smem + LDS_SCR); }
        PG8_RUN(5, WSB(WS_PB) + (size_t)L * T * PLE, WSB(WS_WPP) + (size_t)L * D * PLE, T, D, PLE, PLE, PLE, ({nullptr, D, D, nullptr, 0, nullptr, (bf16_t*)WSF(WS_PPROJ), D, wave_s}));
        BAR();
        { LAUNDER(); ph_light(tid_, bid_, WSB(WS_Z), INP(5) + (size_t)L * 3 * CONVD, WSF(WS_CD), WSF(WS_SD), WSF(WS_CM), WSF(WS_SM), WSB(WS_MIXB), WSF(WS_RSQ), WSF(WS_RSKV)); }
        { LAUNDER(); ph_ssm_local(tid_, bid_, WSB(WS_Z), INP(6) + (size_t)L * NG * NP, INP(7) + (size_t)L * NG * NP, INP(8) + (size_t)L * NG,
                                  INP(9) + (size_t)L * NG * NP * 16, INP(10) + (size_t)L * NG * NP * 16, WSF(WS_X), smem + LDS_SCR); }
        BAR();
        { LAUNDER(); ph_dil_attn_mfma(tid_, bid_, WSB(WS_Z), WSF(WS_OD), WSF(WS_LSE), smem + LDS_SCR); }
        {
            LAUNDER();
            if (bid_ < 128) {
            pg8::Gemm g_{WSB(WS_Z) + OFF_CQ, WSB(WS_WUQ) + (size_t)L * NQ_P * QR, T, NQ_P, QR, DIN, QR};
            pg8::StaticOrder S_; S_.init(T, NQ_P, 128, bid_);
            EpiB16S E_{WSB(WS_QFB), NQ, NQ, WSF(WS_RSQ), nullptr, 0.10206207261596575f * 1.4426950408889634f, wave_s};
            pg8::gemm_phase<EpiB16S, pg8::StaticOrder, true, true>(tid_, (PG8_LAS unsigned char*)(smem + LDS_SCR), g_, S_, E_);
            }
        }
        {
            LAUNDER();
            if (bid_ >= 128 && bid_ < 192) {
            pg8::Gemm g_{WSB(WS_Z) + OFF_CKV, WSB(WS_WKT) + (size_t)L * 768 * KVR, T, 768, KVR, DIN, KVR};
            pg8::StaticOrder S_; S_.init(T, 768, 64, bid_ - 128);
            EpiB16S E_{WSB(WS_KNB), KNP, KNP, WSF(WS_RSKV), nullptr, 1.f, wave_s};
            pg8::gemm_phase<EpiB16S, pg8::StaticOrder, true, true>(tid_, (PG8_LAS unsigned char*)(smem + LDS_SCR), g_, S_, E_);
            }
        }
        {
            LAUNDER();
            if (bid_ >= 192) {
            pg8::Gemm g_{WSB(WS_WVT) + (size_t)L * 768 * KVR, WSB(WS_Z) + OFF_CKV, 768, T, KVR, KVR, DIN};
            pg8::StaticOrder S_; S_.init(768, T, 64, bid_ - 192);
            EpiB16S E_{WSB(WS_VTB), T, T, nullptr, WSF(WS_RSKV), 1.f, wave_s};
            pg8::gemm_phase<EpiB16S, pg8::StaticOrder, true, true>(tid_, (PG8_LAS unsigned char*)(smem + LDS_SCR), g_, S_, E_);
            }
        }
        { LAUNDER(); ph_ssm_final(tid_, bid_, WSB(WS_Z), INP(6) + (size_t)L * NG * NP, INP(7) + (size_t)L * NG * NP, INP(8) + (size_t)L * NG,
                                  INP(9) + (size_t)L * NG * NP * 16, INP(10) + (size_t)L * NG * NP * 16, INP(11) + (size_t)L * NG * 16 * NP, INP(12) + (size_t)L * NG * 16 * NP,
                                  INP(13) + (size_t)L * SSMD, WSF(WS_X), WSF(WS_GV), WSB(WS_GVB), smem + LDS_SCR); }
        BAR();
        {
            LAUNDER();
            if (bid_ >= 192) {
            pg8::Gemm g_{WSB(WS_GVB), WSB(WS_WGLU) + (size_t)L * GLU_P * GLU_P, T, GLU_P, GLU_P, GLU_P, GLU_P};
            pg8::StaticOrder S_; S_.init(T, GLU_P, 64, bid_ - 192);
            EpiG<4> E_({nullptr, 0, SSMD, WSF(WS_GV), SSMD, INP(15) + (size_t)L * SSMD, WSB(WS_MIXB) + 448, D, wave_s});
            pg8::gemm_phase<EpiG<4>, pg8::StaticOrder, true, true>(tid_, (PG8_LAS unsigned char*)(smem + LDS_SCR), g_, S_, E_);
            }
        }
        { LAUNDER(); ph_dil_combine(tid_, bid_, WSF(WS_OD), WSF(WS_LSE), WSB(WS_MIXB)); }
        { LAUNDER(); ph_mla_attn_mfma(tid_, bid_, WSB(WS_QFB), WSB(WS_KNB), WSB(WS_Z), WSB(WS_VTB), WSB(WS_MIXB), WSF(WS_CM), WSF(WS_SM), smem + LDS_SCR); }
        BAR();
        PG8_RUN(1, WSB(WS_MIXB), WSB(WS_WOUT) + (size_t)L * D * D, T, D, D, D, D, ({WSF(WS_H), D, D, nullptr, 0, nullptr, nullptr, 0, wave_s}));
        BAR();
        { LAUNDER(); ph_router_mfma(tid_, bid_, WSF(WS_H), WSF(WS_W2R) + (size_t)L * D * RCOLS, INP(23) + (size_t)L * 8, INP(25) + (size_t)L * NE,
                                    WSI(WS_EIDX), WSF(WS_GATE), WSF(WS_RSBUF), WSI(WS_CNT), smem + LDS_SCR); }
        BAR();
        { LAUNDER(); ph_moe_scatter(tid_, bid_, WSI(WS_EIDX), WSF(WS_GATE), WSI(WS_CNT), WSI(WS_CURSOR), WSF(WS_H), WSF(WS_RSBUF), INP(21) + (size_t)L * D,
                                    WSB(WS_AG), WSF(WS_SLOTGATE), WSI(WS_TOKSLOT), ps, (int*)(smem + LDS_TILEE)); }
        BAR();
        {
            LAUNDER();
            moe_gemm<1>(tid_, bid_, (const LAS int*)(smem_base + LDS_TILEE), WSB(WS_AG), D, D, INP(26) + (size_t)L * NE * D * FF, INP(27) + (size_t)L * NE * D * FF,
                        WSB(WS_ACTB), nullptr, (PG8_LAS unsigned char*)(smem + LDS_SCR));
        }
        BAR();
        {
            LAUNDER();
            moe_gemm<2>(tid_, bid_, (const LAS int*)(smem_base + LDS_TILEE), WSB(WS_ACTB), FF, FF, INP(28) + (size_t)L * NE * FF * D, nullptr,
                        WSB(WS_YB), WSF(WS_SLOTGATE), (PG8_LAS unsigned char*)(smem + LDS_SCR));
        }
        BAR();
        { LAUNDER(); ph_moe_combine_norm(tid_, bid_, WSF(WS_H), WSB(WS_YB), WSI(WS_TOKSLOT), INP(29) + (size_t)L * D, WSB(WS_HNB)); }
        BAR();
        {
            LAUNDER();
            pg8::Gemm g_{WSB(WS_HNB), WSB(WS_WPG) + (size_t)L * D * D, T, D, D, D, D};
            pg8::StaticOrder S_; S_.init(T, D, NBLK, bid_);
            EpiPle E_{WSF(WS_H), (const bf16_t*)WSF(WS_PPROJ), (L0 == 0) ? (INP(3) + D) : INP(32), WSB(WS_HB), WSF(WS_SS) + (size_t)(L + 1) * T, wave_s};
            pg8::gemm_phase<EpiPle, pg8::StaticOrder, true, true>(tid_, (PG8_LAS unsigned char*)(smem + LDS_SCR), g_, S_, E_);
        }
        BAR();
    }
#undef L
    { LAUNDER(); ph_final_norm(tid_, bid_, WSF(WS_H), WSF(WS_SS) + (size_t)2 * T, INP(32), (float*)LDP(33)); }
}
}

extern "C" void kernel_launch(void* const* d_in, const int* in_sizes, int n_in, void* d_out, int out_size, void* d_ws, size_t ws_size,
                              hipStream_t stream) {
    static int grid = 0;
    if (!grid) {
        int dev = 0, cus = 0, per_cu = 0;
        (void)hipGetDevice(&dev);
        (void)hipDeviceGetAttribute(&cus, hipDeviceAttributeMultiprocessorCount, dev);
        if (hipFuncSetAttribute((const void*)mega, hipFuncAttributeMaxDynamicSharedMemorySize, LDS_BYTES) != hipSuccess) fprintf(stderr, "hipFuncSetAttribute failed\n");
        (void)hipOccupancyMaxActiveBlocksPerMultiprocessor(&per_cu, (const void*)mega, NTHR, LDS_BYTES);
        if (per_cu < 1) fprintf(stderr, "occupancy query returned %d\n", per_cu);
        (void)hipGetLastError();
        grid = NBLK;
        if (cus != NBLK) fprintf(stderr, "expected %d CUs, got %d\n", NBLK, cus);
    }
    Params P{};
    for (int i = 0; i < 33; ++i) P.in[i] = (const float*)d_in[i];
    P.out = (float*)d_out;
    P.ws = (unsigned char*)d_ws;
    if (ws_size < WS_END) fprintf(stderr, "ws too small: %zu < %zu\n", ws_size, (size_t)WS_END);
    (void)hipMemsetAsync((char*)d_ws + WS_BAR, 0, XCD_BAR_WORDS * 4, stream);
    hipLaunchKernelGGL(mega, dim3(grid), dim3(NTHR), LDS_BYTES, stream, P);
}
```

```cpp
#include <hip/hip_runtime.h>
#include <stdint.h>
#include <cstdio>

#define XB_TMO      128
#define XB_XCNT(j)  (256  + 64 * (j))
#define XB_XSUB(j)  (1280 + 64 * (j))
#define XB_XGEN(j)  (2304 + 64 * (j))
#define XB_TOP      3328
#define XB_TOPGEN   3392
#define XCD_BAR_WORDS 3456
#define XB_SPIN_CAP (1u << 22)
#define LAS __attribute__((address_space(3)))

__device__ __forceinline__ unsigned xb_ld(unsigned* p)              { return __hip_atomic_load(p, __ATOMIC_RELAXED, __HIP_MEMORY_SCOPE_AGENT); }
__device__ __forceinline__ unsigned xb_add(unsigned* p, unsigned v) { return __hip_atomic_fetch_add(p, v, __ATOMIC_RELAXED, __HIP_MEMORY_SCOPE_AGENT); }
__device__ __forceinline__ unsigned xb_xcc_id() { return (unsigned)__builtin_amdgcn_s_getreg((3 << 11) | 20) & 0xFu; }
#define XB_SPIN(cond, bar) do { unsigned _sp = 0; while (cond) { __builtin_amdgcn_s_sleep(1); \
    if ((++_sp & 255u) == 0u) { if (xb_ld(&(bar)[XB_TMO])) break; if (_sp > XB_SPIN_CAP) { atomicAdd(&(bar)[XB_TMO], 1u); break; } } } } while (0)

struct XcdBarrier { unsigned* bar; unsigned x; volatile LAS unsigned* st; };

__device__ __forceinline__ XcdBarrier xcd_barrier_post(unsigned* bar, volatile LAS unsigned* st, const int tid) {
    XcdBarrier b; b.bar = bar; b.x = xb_xcc_id(); b.st = st;
    if (tid == 0) (void)xb_add(&bar[XB_XCNT(b.x)], 1u);
    return b;
}
__device__ __forceinline__ void xcd_barrier_complete(unsigned* bar, unsigned x, unsigned& nloc, unsigned& nx) {
    const unsigned G = gridDim.x * gridDim.y * gridDim.z;
    unsigned sum, cnt, mine, sp = 0u;
    for (;;) {
        sum = 0u; cnt = 0u; mine = 0u;
#pragma unroll
        for (unsigned j = 0; j < 16; ++j) { const unsigned c = xb_ld(&bar[XB_XCNT(j)]); sum += c; cnt += (c > 0u) ? 1u : 0u; mine = (j == x) ? c : mine; }
        if (sum == G) break;
        __builtin_amdgcn_s_sleep(1);
        if ((++sp & 255u) == 0u) { if (xb_ld(&bar[XB_TMO])) break; if (sp > XB_SPIN_CAP) { atomicAdd(&bar[XB_TMO], 1u); break; } }
    }
    nloc = mine > 0u ? mine : 1u; nx = cnt > 0u ? cnt : 1u;
}
__device__ __forceinline__ void xcd_barrier(const XcdBarrier& b, const int tid) {
    asm volatile("s_waitcnt vmcnt(0)" ::: "memory");
    __syncthreads();
    if (tid == 0) {
        unsigned* bar = b.bar;
        __builtin_amdgcn_s_waitcnt(0);
        unsigned nloc = b.st[0], nx = b.st[1];
        if (nloc == 0u) { xcd_barrier_complete(bar, b.x, nloc, nx); b.st[0] = nloc; b.st[1] = nx; }
        const unsigned old = xb_add(&bar[XB_XSUB(b.x)], 1u);
        const unsigned gen = old / nloc;
        if (old + 1u == (gen + 1u) * nloc) {
            __builtin_amdgcn_fence(__ATOMIC_RELEASE, "agent");
            asm volatile("s_waitcnt vmcnt(0)" ::: "memory");
            const unsigned og = xb_add(&bar[XB_TOP], 1u);
            const unsigned tg = og / nx;
            if (og + 1u == (tg + 1u) * nx) xb_add(&bar[XB_TOPGEN], 1u);
            else XB_SPIN(xb_ld(&bar[XB_TOPGEN]) == tg, bar);
            __builtin_amdgcn_fence(__ATOMIC_ACQUIRE, "agent");
            xb_add(&bar[XB_XGEN(b.x)], 1u);
            asm volatile("s_waitcnt vmcnt(0)" ::: "memory");
        } else {
            XB_SPIN(xb_ld(&bar[XB_XGEN(b.x)]) == gen, bar);
            __builtin_amdgcn_fence(__ATOMIC_ACQUIRE, "agent");
            asm volatile("s_waitcnt vmcnt(0)" ::: "memory");
        }
    }
    __syncthreads();
}

namespace pg8 {
#define PG8_LAS __attribute__((address_space(3)))
typedef unsigned short bf16_t;
typedef short bf16x8 __attribute__((ext_vector_type(8)));
typedef float f32x4 __attribute__((ext_vector_type(4)));
typedef unsigned u32x4 __attribute__((ext_vector_type(4)));
constexpr int BM = 256, BK = 64, HALF = 128, HTB = HALF * BK * 2  , STAGE_BYTES = 8 * HTB, NXCD = 8, WGM = 8;

__host__ __device__ __forceinline__ int lds_byte(int r, int c) { const int st = (r >> 4) * 2 + (c >> 5), rr = r & 15, cc = c & 31, ob = rr * 64 + cc * 2; return st * 1024 + (ob ^ (((ob >> 9) & 1) << 5)); }
__host__ __device__ __forceinline__ void stage_rc(int b, int& R, int& C) { const int st = b / 1024, sb = b % 1024, swz = sb ^ (((sb >> 9) & 1) << 5); R = (st >> 1) * 16 + swz / 64; C = (st & 1) * 32 + (swz % 64) / 2; }
__host__ __device__ __forceinline__ int perm32(int rho) { const int n = rho >> 4, i = rho & 15; return 8 * (i >> 2) + 4 * n + (i & 3); }

struct Unit { int pm, pn; };
struct Gemm { const bf16_t* A; const bf16_t* Bt; int M, N, K, lda, ldb; };

struct StaticOrder {
    int nM, nN, nwg, G, c;
    __host__ __device__ void init(int M, int N, int G_, int c_) { nM = M / BM; nN = N / BM; nwg = nM * nN; G = G_; c = c_; }
    __host__ __device__ bool next(int i, Unit& u) const {
        const long L = (long)i * G + c; if (L >= nwg) return false;
        int wgid = (int)L; { const int q = nwg / NXCD, r = nwg % NXCD, xcd = wgid % NXCD, off = wgid / NXCD; wgid = (xcd < r ? xcd * (q + 1) : r * (q + 1) + (xcd - r) * q) + off; }
        const int nig = WGM * nN, gid = wgid / nig, fm = gid * WGM, gsz = (nM - fm) < WGM ? (nM - fm) : WGM;
        u.pm = fm + ((wgid % nig) % gsz); u.pn = (wgid % nig) / gsz; return true;
    }
    __device__ __forceinline__ void a_ready(const Unit&) const {}
    __device__ __forceinline__ void done(const Unit&) const {}
};

typedef __bf16 bf16x2_pg __attribute__((ext_vector_type(2)));
typedef float f32x2_pg __attribute__((ext_vector_type(2)));
__device__ __forceinline__ unsigned cvt_pk_bf16(float lo, float hi) { const f32x2_pg v = {lo, hi}; return __builtin_bit_cast(unsigned, __builtin_convertvector(v, bf16x2_pg)); }
template <class Epi, class Sched, bool ALIGN_EPI = false, bool SP2 = false>
__device__ __forceinline__ void gemm_phase(const int tid_in, PG8_LAS unsigned char* lds, const Gemm g, const Sched& S, const Epi& E) {
    const int tid = tid_in, wid = __builtin_amdgcn_readfirstlane(tid >> 6), lane = tid & 63, wr = wid >> 2, wc = wid & 3, fr = lane & 15, fq = lane >> 4;
    const int K = g.K, nt = K / BK;
    unsigned voffA[2], voffB[2];
#pragma unroll
    for (int i = 0; i < 2; ++i) { int R, C; stage_rc(tid * 16 + i * 8192, R, C); const int Rb = Epi::PERM ? ((R & ~31) + perm32(R & 31)) : R;
        voffA[i] = (unsigned)(R * g.lda + C) * 2u; voffB[i] = (unsigned)(Rb * g.ldb + C) * 2u; }
    const size_t kstep = (size_t)(BK * 2);
    const size_t hstepA = (size_t)HALF * g.lda * 2, hstepB = (size_t)HALF * g.ldb * 2;
    const size_t tstepA = 2 * hstepA, tstepB = 2 * hstepB;
    const unsigned ldsw = (unsigned)wid * 1024u;
    const int aoff = lds_byte(wr * 64 + fr, fq * 8), boff = lds_byte(wc * 32 + fr, fq * 8);
#define PG8_SA(b, h) (((b) * 2 + (h)) * HTB)
#define PG8_SB(b, h) ((4 + (b) * 2 + (h)) * HTB)
#define PG8_STAGE(bufoff, gbase, voff) do { _Pragma("unroll") for (int _i = 0; _i < 2; ++_i) \
        __builtin_amdgcn_global_load_lds((const unsigned*)((const char*)(gbase) + (voff)[_i]), (PG8_LAS unsigned*)(lds + (bufoff) + ldsw + _i * 8192), 16, 0, 0); } while (0)
#define PG8_LDA(dst, b, h) do { _Pragma("unroll") for (int m = 0; m < 4; ++m) _Pragma("unroll") for (int k = 0; k < 2; ++k) dst[m][k] = *(const PG8_LAS bf16x8*)(lds + PG8_SA(b, h) + aoff + m * 2048 + k * 1024); } while (0)
#define PG8_LDB(dst, b, h) do { _Pragma("unroll") for (int n = 0; n < 2; ++n) _Pragma("unroll") for (int k = 0; k < 2; ++k) dst[n][k] = *(const PG8_LAS bf16x8*)(lds + PG8_SB(b, h) + boff + n * 2048 + k * 1024); } while (0)
#define PG8_MMA(ai, bj, At, Bt) do { __builtin_amdgcn_s_setprio(1); _Pragma("unroll") for (int m = 0; m < 4; ++m) _Pragma("unroll") for (int n = 0; n < 2; ++n) _Pragma("unroll") for (int k = 0; k < 2; ++k) \
        acc[ai][bj][m][n] = __builtin_amdgcn_mfma_f32_16x16x32_bf16(Bt[n][k], At[m][k], acc[ai][bj][m][n], 0, 0, 0); __builtin_amdgcn_s_setprio(0); } while (0)
#define PG8_WAIT_V(n) asm volatile("s_waitcnt vmcnt(" #n ")" ::: "memory")
#define PG8_WAIT_L(n) asm volatile("s_waitcnt lgkmcnt(" #n ")" ::: "memory")
#define PG8_BAR __builtin_amdgcn_s_barrier()
#define PG8_SCHED __builtin_amdgcn_sched_barrier(0)
    Unit cur, nxt; int ui = 0;
    if (!S.next(0, cur)) return;
    f32x4 acc[2][2][4][2];
#pragma unroll
    for (int a = 0; a < 2; ++a)
#pragma unroll
        for (int b = 0; b < 2; ++b)
#pragma unroll
            for (int m = 0; m < 4; ++m)
#pragma unroll
                for (int n = 0; n < 2; ++n) acc[a][b][m][n] = (f32x4){0.f, 0.f, 0.f, 0.f};
    bf16x8 At[4][2], B0[2][2], B1[2][2];
    const char* cA = (const char*)g.A + (size_t)cur.pm * tstepA; const char* cB = (const char*)g.Bt + (size_t)cur.pn * tstepB;
    S.a_ready(cur);
    if constexpr (SP2) {
        PG8_STAGE(PG8_SB(0, 0), cB, voffB); PG8_STAGE(PG8_SB(0, 1), cB + hstepB, voffB); PG8_STAGE(PG8_SA(0, 0), cA, voffA); PG8_STAGE(PG8_SA(0, 1), cA + hstepA, voffA);
        if (wr == 1) PG8_BAR;
        PG8_WAIT_V(2); PG8_BAR;
        PG8_STAGE(PG8_SB(1, 0), cB + kstep, voffB); PG8_STAGE(PG8_SA(1, 0), cA + kstep, voffA); PG8_STAGE(PG8_SB(1, 1), cB + hstepB + kstep, voffB);
        PG8_WAIT_V(6); PG8_BAR;
    } else {
        PG8_STAGE(PG8_SB(0, 0), cB, voffB); PG8_STAGE(PG8_SA(0, 0), cA, voffA); PG8_STAGE(PG8_SB(0, 1), cB + hstepB, voffB); PG8_STAGE(PG8_SA(0, 1), cA + hstepA, voffA);
        if (wr == 1) PG8_BAR;
        PG8_WAIT_V(4); PG8_BAR;
        PG8_STAGE(PG8_SB(1, 0), cB + kstep, voffB); PG8_STAGE(PG8_SA(1, 0), cA + kstep, voffA); PG8_STAGE(PG8_SB(1, 1), cB + hstepB + kstep, voffB);
        PG8_WAIT_V(6); PG8_BAR;
    }
    for (;;) {
        const bool has_next = S.next(ui + 1, nxt);
        const char* nA = has_next ? (const char*)g.A + (size_t)nxt.pm * tstepA : cA; const char* nB = has_next ? (const char*)g.Bt + (size_t)nxt.pn * tstepB : cB;
        for (int t = 0; t < nt; t += 2) {
            const bool last = (t == nt - 2);
            const char* a1 = cA + (size_t)(t + 1) * kstep;
            const char* a2 = last ? nA : cA + (size_t)(t + 2) * kstep; const char* b2 = last ? nB : cB + (size_t)(t + 2) * kstep;
            const char* a3 = a2 + kstep; const char* b3 = b2 + kstep;
            if (last && has_next) S.a_ready(nxt);
            if constexpr (SP2) {
            PG8_LDB(B0, 0, 0); PG8_LDB(B1, 0, 1); PG8_SCHED; PG8_LDA(At, 0, 0); PG8_STAGE(PG8_SA(1, 1), a1 + hstepA, voffA);
            PG8_WAIT_V(8); PG8_WAIT_L(0); PG8_BAR; PG8_MMA(0, 0, At, B0); PG8_MMA(0, 1, At, B1); PG8_BAR; PG8_SCHED;
            PG8_LDA(At, 0, 1); PG8_STAGE(PG8_SB(0, 0), b2, voffB); PG8_STAGE(PG8_SB(0, 1), b2 + hstepB, voffB); PG8_STAGE(PG8_SA(0, 0), a2, voffA);
            PG8_WAIT_V(8); PG8_WAIT_L(0); PG8_BAR; PG8_MMA(1, 0, At, B0); PG8_MMA(1, 1, At, B1); PG8_BAR; PG8_SCHED;
            PG8_LDB(B0, 1, 0); PG8_LDB(B1, 1, 1); PG8_SCHED; PG8_LDA(At, 1, 0); PG8_STAGE(PG8_SA(0, 1), a2 + hstepA, voffA);
            PG8_WAIT_V(8); PG8_WAIT_L(0); PG8_BAR; PG8_MMA(0, 0, At, B0); PG8_MMA(0, 1, At, B1); PG8_BAR; PG8_SCHED;
            PG8_LDA(At, 1, 1); PG8_STAGE(PG8_SB(1, 0), b3, voffB); PG8_STAGE(PG8_SB(1, 1), b3 + hstepB, voffB); PG8_STAGE(PG8_SA(1, 0), a3, voffA);
            PG8_WAIT_V(8); PG8_WAIT_L(0); PG8_BAR; PG8_MMA(1, 0, At, B0); PG8_MMA(1, 1, At, B1); PG8_BAR; PG8_SCHED;
            } else {
            PG8_LDB(B0, 0, 0); PG8_SCHED; PG8_LDA(At, 0, 0); PG8_STAGE(PG8_SA(1, 1), a1 + hstepA, voffA);
            PG8_WAIT_L(8); PG8_BAR; PG8_WAIT_L(0); PG8_MMA(0, 0, At, B0); PG8_BAR; PG8_SCHED;
            PG8_LDB(B1, 0, 1); PG8_STAGE(PG8_SB(0, 0), b2, voffB);
            PG8_BAR; PG8_WAIT_L(0); PG8_MMA(0, 1, At, B1); PG8_BAR;
            PG8_LDA(At, 0, 1); PG8_STAGE(PG8_SA(0, 0), a2, voffA);
            PG8_BAR; PG8_WAIT_L(0); PG8_MMA(1, 0, At, B0); PG8_BAR; PG8_SCHED;
            PG8_STAGE(PG8_SB(0, 1), b2 + hstepB, voffB);
            PG8_WAIT_V(6); PG8_BAR; PG8_MMA(1, 1, At, B1); PG8_BAR;
            PG8_LDB(B0, 1, 0); PG8_SCHED; PG8_LDA(At, 1, 0); PG8_STAGE(PG8_SA(0, 1), a2 + hstepA, voffA);
            PG8_WAIT_L(8); PG8_BAR; PG8_WAIT_L(0); PG8_MMA(0, 0, At, B0); PG8_BAR; PG8_SCHED;
            PG8_LDB(B1, 1, 1); PG8_STAGE(PG8_SB(1, 0), b3, voffB);
            PG8_BAR; PG8_WAIT_L(0); PG8_MMA(0, 1, At, B1); PG8_BAR;
            PG8_LDA(At, 1, 1); PG8_STAGE(PG8_SA(1, 0), a3, voffA);
            PG8_BAR; PG8_WAIT_L(0); PG8_MMA(1, 0, At, B0); PG8_BAR; PG8_SCHED;
            PG8_STAGE(PG8_SB(1, 1), b3 + hstepB, voffB);
            PG8_WAIT_V(6); PG8_BAR; PG8_MMA(1, 1, At, B1); PG8_BAR;
            }
        }
        if constexpr (ALIGN_EPI) { if (wr == 0) PG8_BAR; }
        if constexpr (!Epi::AFTER_DRAIN) { E(acc, cur, wr, wc, fr, fq); S.done(cur); }
        if (!has_next) break;
#pragma unroll
        for (int a = 0; a < 2; ++a)
#pragma unroll
            for (int b = 0; b < 2; ++b)
#pragma unroll
                for (int m = 0; m < 4; ++m)
#pragma unroll
                    for (int n = 0; n < 2; ++n) acc[a][b][m][n] = (f32x4){0.f, 0.f, 0.f, 0.f};
        cur = nxt; cA = nA; cB = nB; ++ui;
        if constexpr (ALIGN_EPI) { if (wr == 1) PG8_BAR; }
    }
    PG8_WAIT_V(0);
    if constexpr (!ALIGN_EPI) { if (wr == 0) PG8_BAR; }
    PG8_BAR;
    if constexpr (Epi::AFTER_DRAIN) { E.fused(acc, cur, wr, wc, fr, fq, lds, wid, lane); S.done(cur); }
#undef PG8_SA
#undef PG8_SB
#undef PG8_STAGE
#undef PG8_LDA
#undef PG8_LDB
#undef PG8_MMA
#undef PG8_WAIT_V
#undef PG8_WAIT_L
#undef PG8_BAR
#undef PG8_SCHED
}
}

namespace {
constexpr int NB = 4, S = 2048, D = 2048, T = NB * S, DEPTH = 2, PLE = 256, DIN = 4192;
constexpr int CONVD = 448, SSMD = 448, NG = 28, NP = 64, DILD = 576, MLAD = 576;
constexpr int OFF_CB = 0, OFF_CC = 448, OFF_CH = 896, OFF_SU = 1344, OFF_DQ = 1792, OFF_DK = 2368, OFF_DV = 2944,
              OFF_CQ = 3520, OFF_CKV = 3904, OFF_KR = 4160;
constexpr int QR = 384, KVR = 256, NQ = 864, NKV = 1152;
constexpr int NE = 64, FF = 512, MT = 320, PSLOT = 36864, NTILE = 128;
constexpr float EPS = 1e-6f;
constexpr int GLU_P = 512;
constexpr int NTHR = 512, NBLK = 256;

typedef unsigned short bf16_t;
__device__ __forceinline__ unsigned f2bf(float f) { unsigned u = __builtin_bit_cast(unsigned, f); return (u + 0x7fffu + ((u >> 16) & 1u)) >> 16; }
typedef __bf16 bf16x2_hw __attribute__((ext_vector_type(2)));
typedef float f32x2_hw __attribute__((ext_vector_type(2)));
__device__ __forceinline__ unsigned pk2(float lo, float hi) { const f32x2_hw v = {lo, hi}; return __builtin_bit_cast(unsigned, __builtin_convertvector(v, bf16x2_hw)); }
__device__ __forceinline__ float shflx(float v, int mask, int lane) { return __builtin_bit_cast(float, __builtin_amdgcn_ds_bpermute((lane ^ mask) << 2, __builtin_bit_cast(int, v))); }
#define GAS __attribute__((address_space(1)))
typedef unsigned u32x4_t __attribute__((ext_vector_type(4)));
typedef unsigned u32x2_t __attribute__((ext_vector_type(2)));
typedef float f32x4_t __attribute__((ext_vector_type(4)));
__device__ __forceinline__ uint4 ldg16(const GAS void* p) { const u32x4_t v = *(const GAS u32x4_t*)p; return make_uint4(v.x, v.y, v.z, v.w); }
__device__ __forceinline__ uint2 ldg8(const GAS void* p) { const u32x2_t v = *(const GAS u32x2_t*)p; return make_uint2(v.x, v.y); }
__device__ __forceinline__ float4 ldgf4(const GAS void* p) { const f32x4_t v = *(const GAS f32x4_t*)p; return make_float4(v.x, v.y, v.z, v.w); }
__device__ __forceinline__ void stg16(GAS void* p, uint4 v) { u32x4_t w; w.x = v.x; w.y = v.y; w.z = v.z; w.w = v.w; *(GAS u32x4_t*)p = w; }
__device__ __forceinline__ void stg8(GAS void* p, uint2 v) { u32x2_t w; w.x = v.x; w.y = v.y; *(GAS u32x2_t*)p = w; }
__device__ __forceinline__ void pair_store_bf16(GAS bf16_t* rowbase, int c0, int c1, unsigned a0, unsigned a1, unsigned b0, unsigned b1, int fq) {
    const auto rx = __builtin_amdgcn_permlane16_swap(a0, b0, false, false); const unsigned x0 = rx[0], x1 = rx[1];
    const auto ry = __builtin_amdgcn_permlane16_swap(a1, b1, false, false); const unsigned y0 = ry[0], y1 = ry[1];
    u32x4_t w; w.x = x0; w.y = y0; w.z = x1; w.w = y1;
    *(GAS u32x4_t*)(rowbase + ((fq & 1) ? c1 : c0) + 8 * (fq >> 1)) = w;
}
#define GTID() ((long)bid_ * NTHR + tid_)
#define GSTRIDE() ((long)NBLK * NTHR)


__device__ inline void sincos_d(double a, double& s, double& c) {
    const double k = rint(a * 0.15915494309189535);
    double r = fma(-k, 6.283185307179586, a);
    r = fma(-k, 2.4492935982947064e-16, r);
    const double r2 = r * r;
    double ss = 0.0, cc = 0.0;
#pragma unroll
    for (int n = 14; n >= 1; --n) {
        ss = (ss + 1.0) * (-r2 / (double)((2 * n) * (2 * n + 1)));
        cc = (cc + 1.0) * (-r2 / (double)((2 * n - 1) * (2 * n)));
    }
    s = r * (1.0 + ss);
    c = 1.0 + cc;
}
__device__ __forceinline__ void ph_rope_tab(const int tid_, const int bid_, const int* pos, float* cd, float* sd, float* cm, float* sm) {
    for (long i = GTID(); i < (long)T * 24; i += GSTRIDE()) {
        const int t = (int)(i / 24), j = (int)(i % 24);
        const double LN_THETA = 13.122363377404328;
        double s, c;
        if (j < 8) {
            const double f = exp(-(double)j / 8.0 * LN_THETA);
            sincos_d((double)pos[t] * f, s, c);
            cd[t * 8 + j] = (float)c; sd[t * 8 + j] = (float)s;
        } else {
            const int jj = j - 8;
            const double f = exp(-(double)jj / 16.0 * LN_THETA);
            sincos_d((double)pos[t] * f, s, c);
            cm[t * 16 + jj] = (float)c; sm[t * 16 + jj] = (float)s;
        }
    }
}


__device__ inline float gelu_tanh(float x) {
    const float k = 0.7978845608028654f;
    return x * __builtin_amdgcn_rcpf(1.f + __expf(-2.f * k * (x + 0.044715f * x * x * x)));
}


constexpr int SCH = 64, NCH = S / SCH;
struct SsmCoef { float ar, ai; float cr[16], ci[16]; };
__device__ __forceinline__ void ssm_setup(SsmCoef& k, int g, int p, const float* lam_re, const float* lam_im, const float* log_dt, const float* b_re, const float* b_im) {
    const float lr = lam_re[g * NP + p], li = lam_im[g * NP + p];
    const float dt = expf(log_dt[g]);
    const float mag = expf(lr * dt);
    k.ar = mag * cosf(li * dt); k.ai = mag * sinf(li * dt);
    const float nr = k.ar - 1.f, ni = k.ai, den = lr * lr + li * li;
    const float fr = (nr * lr + ni * li) / den, fi = (ni * lr - nr * li) / den;
#pragma unroll
    for (int c4 = 0; c4 < 4; ++c4) {
        const float4 br = *(const float4*)(b_re + (g * NP + p) * 16 + 4 * c4), bi = *(const float4*)(b_im + (g * NP + p) * 16 + 4 * c4);
        k.cr[4 * c4 + 0] = fr * br.x - fi * bi.x; k.ci[4 * c4 + 0] = fr * bi.x + fi * br.x;
        k.cr[4 * c4 + 1] = fr * br.y - fi * bi.y; k.ci[4 * c4 + 1] = fr * bi.y + fi * br.y;
        k.cr[4 * c4 + 2] = fr * br.z - fi * bi.z; k.ci[4 * c4 + 2] = fr * bi.z + fi * br.z;
        k.cr[4 * c4 + 3] = fr * br.w - fi * bi.w; k.ci[4 * c4 + 3] = fr * bi.w + fi * br.w;
    }
}
#define BFLO(w) __builtin_bit_cast(float, (w) << 16)
#define BFHI(w) __builtin_bit_cast(float, (w) & 0xffff0000u)
#define SSM_STEP(up) do { const u32x4_t ua_ = *(const LAS u32x4_t*)(up), ub_ = *(const LAS u32x4_t*)((up) + 16); const uint4 u0_ = make_uint4(ua_.x, ua_.y, ua_.z, ua_.w), u1_ = make_uint4(ub_.x, ub_.y, ub_.z, ub_.w); \
    const float uu_[16] = {BFLO(u0_.x), BFHI(u0_.x), BFLO(u0_.y), BFHI(u0_.y), BFLO(u0_.z), BFHI(u0_.z), BFLO(u0_.w), BFHI(u0_.w), \
                           BFLO(u1_.x), BFHI(u1_.x), BFLO(u1_.y), BFHI(u1_.y), BFLO(u1_.z), BFHI(u1_.z), BFLO(u1_.w), BFHI(u1_.w)}; \
    float sra_[4] = {0.f, 0.f, 0.f, 0.f}, sia_[4] = {0.f, 0.f, 0.f, 0.f}; \
    _Pragma("unroll") for (int c_ = 0; c_ < 16; ++c_) { sra_[c_ & 3] = fmaf(uu_[c_], k.cr[c_], sra_[c_ & 3]); sia_[c_ & 3] = fmaf(uu_[c_], k.ci[c_], sia_[c_ & 3]); } \
    const float sr_ = (sra_[0] + sra_[1]) + (sra_[2] + sra_[3]), si_ = (sia_[0] + sia_[1]) + (sia_[2] + sia_[3]); \
    const float nxr_ = fmaf(k.ar, xr, fmaf(-k.ai, xi, sr_)), nxi_ = fmaf(k.ar, xi, fmaf(k.ai, xr, si_)); xr = nxr_; xi = nxi_; } while (0)

__device__ __forceinline__ void ph_ssm_local(const int tid_, const int bid_, const bf16_t* z_gen, const float* lam_re, const float* lam_im, const float* log_dt,
                                             const float* b_re, const float* b_im, float* E_gen, unsigned char* lds) {
    const GAS bf16_t* z = (const GAS bf16_t*)z_gen;
    GAS float* E = (GAS float*)E_gen;
    const unsigned ul = (unsigned)(size_t)(LAS unsigned char*)lds + (unsigned)(tid_ >> 6) * 2048u;

    const int p = tid_ & 63;
    for (int unit = bid_ * 8 + (tid_ >> 6); unit < NB * NG * NCH; unit += NBLK * 8) {
        const int c = unit % NCH, bg = unit / NCH, g = bg % NG, b = bg / NG;
        SsmCoef k; ssm_setup(k, g, p, lam_re, lam_im, log_dt, b_re, b_im);
        float xr = 0.f, xi = 0.f;
        const GAS bf16_t* zu = z + ((size_t)b * S + (size_t)c * SCH) * DIN + OFF_SU + g * 16;
        {
            const u32x4_t a0 = *(const GAS u32x4_t*)(zu + (size_t)p * DIN), a1 = *(const GAS u32x4_t*)(zu + (size_t)p * DIN + 8);
            *(LAS u32x4_t*)(ul + 32 * p) = a0; *(LAS u32x4_t*)(ul + 32 * p + 16) = a1;
            asm volatile("s_waitcnt lgkmcnt(0)" ::: "memory");
        }
#pragma unroll 8
        for (int t = 0; t < SCH; ++t) SSM_STEP((LAS unsigned char*)(ul + 32 * t));
        asm volatile("s_waitcnt lgkmcnt(0)" ::: "memory");
        GAS float* e = E + ((size_t)bg * NCH + c) * 128;
        e[p] = xr; e[64 + p] = xi;
    }
}
__device__ __forceinline__ void ph_ssm_final(const int tid_, const int bid_, const bf16_t* z_gen, const float* lam_re, const float* lam_im, const float* log_dt,
                                             const float* b_re, const float* b_im, const float* c_re, const float* c_im, const float* dsk, const float* E_gen,
                                             float* gv_gen, bf16_t* gvb_gen, unsigned char* lds) {
    const GAS bf16_t* z = (const GAS bf16_t*)z_gen;
    const GAS float* E = (const GAS float*)E_gen;
    GAS float* gv = (GAS float*)gv_gen;
    GAS bf16_t* gvb = (GAS bf16_t*)gvb_gen;

    typedef float f32x4 __attribute__((ext_vector_type(4)));
    const int p = tid_ & 63, wv = tid_ >> 6, li_ = p & 15, kq = p >> 4;
    float* Xl = (float*)(lds + wv * (16 * 132 * 4));
    const unsigned ul = (unsigned)(size_t)(LAS unsigned char*)lds + 8u * (16 * 132 * 4) + (unsigned)wv * 2048u;
    for (int unit = bid_ * 8 + wv; unit < NB * NG * NCH; unit += NBLK * 8) {
        const int c = unit % NCH, bg = unit / NCH, g = bg % NG, b = bg / NG;
        SsmCoef k; ssm_setup(k, g, p, lam_re, lam_im, log_dt, b_re, b_im);
        float cm[32];
        {
            const float* src = ((kq < 2) ? c_re : c_im) + (size_t)(g * 16 + li_) * NP + 32 * (kq & 1);
            const float sg = (kq < 2) ? 1.f : -1.f;
#pragma unroll
            for (int i = 0; i < 8; ++i) { const float4 v = *(const float4*)(src + 4 * i); cm[4 * i] = sg * v.x; cm[4 * i + 1] = sg * v.y; cm[4 * i + 2] = sg * v.z; cm[4 * i + 3] = sg * v.w; }
        }
        const float dk = dsk[g * 16 + li_];
        float xr = 0.f, xi = 0.f;
        {
            float a64r = k.ar, a64i = k.ai;
#pragma unroll
            for (int i = 0; i < 6; ++i) { const float r2 = a64r * a64r - a64i * a64i, i2 = 2.f * a64r * a64i; a64r = r2; a64i = i2; }
            const GAS float* ep = E + (size_t)bg * NCH * 128;
            for (int cc = 0; cc < c; ++cc) {
                const float er = ep[cc * 128 + p], ei = ep[cc * 128 + 64 + p];
                const float nr = a64r * xr - a64i * xi + er, ni = a64r * xi + a64i * xr + ei;
                xr = nr; xi = ni;
            }
        }
        const size_t t0 = (size_t)b * S + (size_t)c * SCH;
        const GAS bf16_t* zu = z + t0 * DIN + OFF_SU + g * 16;
        {
            const u32x4_t a0 = *(const GAS u32x4_t*)(zu + (size_t)p * DIN), a1 = *(const GAS u32x4_t*)(zu + (size_t)p * DIN + 8);
            *(LAS u32x4_t*)(ul + 32 * p) = a0; *(LAS u32x4_t*)(ul + 32 * p + 16) = a1;
            asm volatile("s_waitcnt lgkmcnt(0)" ::: "memory");
        }
        for (int sb = 0; sb < SCH / 16; ++sb) {
#pragma unroll 8
            for (int tt = 0; tt < 16; ++tt) {
                SSM_STEP((LAS unsigned char*)(ul + 32 * (sb * 16 + tt)));
                Xl[tt * 132 + p] = xr; Xl[tt * 132 + 64 + p] = xi;
            }
            asm volatile("s_waitcnt lgkmcnt(0)" ::: "memory");
            f32x4 af[8];
#pragma unroll
            for (int i = 0; i < 8; ++i) af[i] = *(const f32x4*)(Xl + li_ * 132 + 32 * kq + 4 * i);
            f32x4 acc = (f32x4){0.f, 0.f, 0.f, 0.f};
#pragma unroll
            for (int s2 = 0; s2 < 32; ++s2) acc = __builtin_amdgcn_mfma_f32_16x16x4f32(af[s2 >> 2][s2 & 3], cm[s2], acc, 0, 0, 0);
            asm volatile("s_waitcnt lgkmcnt(0)" ::: "memory");
#pragma unroll
            for (int r = 0; r < 4; ++r) {
                const size_t t = t0 + sb * 16 + 4 * kq + r;
                const float uv = __builtin_bit_cast(float, (unsigned)(*(const LAS bf16_t*)(ul + 32 * (sb * 16 + 4 * kq + r) + 2 * li_)) << 16);
                const float gl = gelu_tanh(acc[r] + dk * uv);
                gv[t * SSMD + g * 16 + li_] = gl;
                gvb[t * GLU_P + g * 16 + li_] = (bf16_t)f2bf(gl);
            }
        }
    }
}

__device__ __forceinline__ void ph_dil_combine(const int tid_, const int bid_, const float* od_gen, const float* lse_gen, bf16_t* mixb_gen) {
    const GAS float* od = (const GAS float*)od_gen;
    const GAS float* lse = (const GAS float*)lse_gen;
    GAS bf16_t* mixb = (GAS bf16_t*)mixb_gen;
    for (long i = GTID(); i < (long)T * (DILD / 8); i += GSTRIDE()) {
        const int t = (int)(i / (DILD / 8)), col = (int)(i % (DILD / 8)) * 8, head = col >> 6, g = head / 3, hg = head % 3;
        const float l0 = lse[(long)t * 9 + hg], l1 = lse[(long)t * 9 + 3 + hg], l2 = lse[(long)t * 9 + 6 + hg];
        const float m = fmaxf(l0, fmaxf(l1, l2));
        const float e0 = __expf(l0 - m), e1 = __expf(l1 - m), e2 = __expf(l2 - m);
        const float eg = (g == 0) ? e0 : (g == 1 ? e1 : e2);
        const float w = eg * __builtin_amdgcn_rcpf(e0 + e1 + e2);
        const float4 v0 = ldgf4((const GAS void*)(od + (long)t * DILD + col)), v1 = ldgf4((const GAS void*)(od + (long)t * DILD + col + 4));
        stg16((GAS void*)(mixb + (long)t * D + 896 + col), make_uint4(pk2(v0.x * w, v0.y * w), pk2(v0.z * w, v0.w * w), pk2(v1.x * w, v1.y * w), pk2(v1.z * w, v1.w * w)));
    }
}


constexpr int DK_ROW = 72, DV_ROW = 68;
constexpr int DK_BYTES = 64 * DK_ROW * 2, DV_BYTES = 64 * DV_ROW * 2;
__device__ __forceinline__ void ph_dil_attn_mfma(const int tid_, const int bid_, const bf16_t* zb_gen, float* od_gen, float* lse_gen, unsigned char* lds) {
    const GAS bf16_t* zb = (const GAS bf16_t*)zb_gen;
    GAS float* od = (GAS float*)od_gen;
    GAS float* lse = (GAS float*)lse_gen;

    typedef short bf16x8 __attribute__((ext_vector_type(8)));
    typedef float f32x4 __attribute__((ext_vector_type(4)));
    const int lane = tid_ & 63, wv = tid_ >> 6, li = lane & 15, lq = lane >> 4;
    const int skey = tid_ >> 3, spart = tid_ & 7;
    for (int idx = bid_; idx < 576; idx += NBLK) {
        const int u = idx & 15, bh = idx >> 4, b = bh / 9, head = bh % 9, g = head / 3;
        const int dil = (g == 0) ? 1 : (g == 1 ? 4 : 16);
        const int i_q = (g == 0) ? u : (g == 1 ? (u & 3) : 0), m_res = (g == 0) ? 0 : (g == 1 ? (u >> 2) : u);
        const int q0 = i_q * 128, qw = q0 + wv * 16;
        const size_t tb = (size_t)b * S + m_res;
        bf16x8 qf[2];
#pragma unroll
        for (int ks = 0; ks < 2; ++ks) qf[ks] = *(const GAS bf16x8*)(zb + (tb + (size_t)(qw + li) * dil) * DIN + OFF_DQ + head * 64 + 32 * ks + 8 * lq);
        f32x4 o[4];
#pragma unroll
        for (int dt = 0; dt < 4; ++dt) o[dt] = (f32x4){0.f, 0.f, 0.f, 0.f};
        float mrun = -1e30f, lrun = 0.f;
        const int kb_lo = (i_q == 0) ? 0 : (2 * i_q - 2), kb_hi = 2 * i_q + 2;
        uint4 rk, rv;
        {
            const size_t tk = tb + (size_t)(kb_lo * 64 + skey) * dil;
            rk = ldg16((const GAS void*)(zb + tk * DIN + OFF_DK + head * 64 + 8 * spart));
            rv = ldg16((const GAS void*)(zb + tk * DIN + OFF_DV + head * 64 + 8 * spart));
        }
        __syncthreads();
        {
            *(uint4*)(lds + (skey * DK_ROW + 8 * spart) * 2) = rk;
            bf16_t* vt = (bf16_t*)(lds + 2 * DK_BYTES);
            const unsigned w[4] = {rv.x, rv.y, rv.z, rv.w};
#pragma unroll
            for (int e = 0; e < 8; ++e) vt[(8 * spart + e) * DV_ROW + skey] = (bf16_t)((w[e >> 1] >> ((e & 1) * 16)) & 0xffffu);
        }
        __syncthreads();
        for (int kb = kb_lo; kb < kb_hi; ++kb) {
            const int k0 = kb * 64, par = (kb - kb_lo) & 1;
            const bool has_next = (kb + 1 < kb_hi);
            if (has_next) {
                const size_t tk = tb + (size_t)(k0 + 64 + skey) * dil;
                rk = ldg16((const GAS void*)(zb + tk * DIN + OFF_DK + head * 64 + 8 * spart));
                rv = ldg16((const GAS void*)(zb + tk * DIN + OFF_DV + head * 64 + 8 * spart));
            }
            if (k0 <= qw + 15 && k0 + 63 >= qw - 128) {
                const unsigned char* kt = lds + par * DK_BYTES;
                const unsigned char* vt = lds + 2 * DK_BYTES + par * DV_BYTES;
                bf16x8 kf[4][2], vf[4][2];
#pragma unroll
                for (int ti = 0; ti < 4; ++ti)
#pragma unroll
                    for (int ks = 0; ks < 2; ++ks) kf[ti][ks] = *(const bf16x8*)(kt + ((16 * ti + li) * DK_ROW + 32 * ks + 8 * lq) * 2);
#pragma unroll
                for (int dt = 0; dt < 4; ++dt)
#pragma unroll
                    for (int s2 = 0; s2 < 2; ++s2) {
                        const unsigned char* vp = vt + ((16 * dt + li) * DV_ROW + 32 * s2 + 4 * lq) * 2;
                        const uint2 lo = *(const uint2*)vp, hi = *(const uint2*)(vp + 32);
                        const uint4 w = make_uint4(lo.x, lo.y, hi.x, hi.y);
                        vf[dt][s2] = __builtin_bit_cast(bf16x8, w);
                    }
                __builtin_amdgcn_sched_barrier(0);
                f32x4 sc[4];
#pragma unroll
                for (int ti = 0; ti < 4; ++ti) {
                    sc[ti] = (f32x4){0.f, 0.f, 0.f, 0.f};
#pragma unroll
                    for (int ks = 0; ks < 2; ++ks) sc[ti] = __builtin_amdgcn_mfma_f32_16x16x32_bf16(kf[ti][ks], qf[ks], sc[ti], 0, 0, 0);
                }
                if (k0 + 63 > qw || k0 < qw + 15 - 128) {
                    const int qpos = qw + li;
#pragma unroll
                    for (int ti = 0; ti < 4; ++ti)
#pragma unroll
                        for (int e = 0; e < 4; ++e) { const int key = k0 + 16 * ti + 4 * lq + e; if (key > qpos || key < qpos - 128) sc[ti][e] = -1e30f; }
                }
                float mx = -1e30f;
#pragma unroll
                for (int ti = 0; ti < 4; ++ti)
#pragma unroll
                    for (int e = 0; e < 4; ++e) mx = fmaxf(mx, sc[ti][e]);
                mx = fmaxf(mx, shflx(mx, 16, lane)); mx = fmaxf(mx, shflx(mx, 32, lane));
                const float mnew = fmaxf(mrun, mx);
                const float alpha = __builtin_amdgcn_exp2f(mrun - mnew);
                float rs = 0.f;
#pragma unroll
                for (int ti = 0; ti < 4; ++ti)
#pragma unroll
                    for (int e = 0; e < 4; ++e) { const float p = (sc[ti][e] > -1e29f) ? __builtin_amdgcn_exp2f(sc[ti][e] - mnew) : 0.f; sc[ti][e] = p; rs += p; }
                rs += shflx(rs, 16, lane); rs += shflx(rs, 32, lane);
                lrun = lrun * alpha + rs; mrun = mnew;
#pragma unroll
                for (int dt = 0; dt < 4; ++dt) o[dt] = o[dt] * alpha;
                bf16x8 pb[2];
#pragma unroll
                for (int s2 = 0; s2 < 2; ++s2) {
                    const uint4 w = make_uint4(pk2(sc[2 * s2][0], sc[2 * s2][1]), pk2(sc[2 * s2][2], sc[2 * s2][3]), pk2(sc[2 * s2 + 1][0], sc[2 * s2 + 1][1]), pk2(sc[2 * s2 + 1][2], sc[2 * s2 + 1][3]));
                    pb[s2] = __builtin_bit_cast(bf16x8, w);
                }
#pragma unroll
                for (int dt = 0; dt < 4; ++dt)
#pragma unroll
                    for (int s2 = 0; s2 < 2; ++s2) o[dt] = __builtin_amdgcn_mfma_f32_16x16x32_bf16(vf[dt][s2], pb[s2], o[dt], 0, 0, 0);
            }
            if (has_next) {
                *(uint4*)(lds + (par ^ 1) * DK_BYTES + (skey * DK_ROW + 8 * spart) * 2) = rk;
                bf16_t* vtw = (bf16_t*)(lds + 2 * DK_BYTES + (par ^ 1) * DV_BYTES);
                const unsigned w[4] = {rv.x, rv.y, rv.z, rv.w};
#pragma unroll
                for (int e = 0; e < 8; ++e) vtw[(8 * spart + e) * DV_ROW + skey] = (bf16_t)((w[e >> 1] >> ((e & 1) * 16)) & 0xffffu);
            }
            __syncthreads();
        }
        const float inv = __builtin_amdgcn_rcpf(lrun);
        const size_t tq = tb + (size_t)(qw + li) * dil;
        GAS float* op = od + tq * DILD + head * 64 + 4 * lq;
#pragma unroll
        for (int dt = 0; dt < 4; ++dt) *(GAS f32x4*)(op + 16 * dt) = o[dt] * inv;
        if (lq == 0) lse[tq * 9 + head] = (mrun + __builtin_amdgcn_logf(lrun)) * 0.6931471805599453f;
    }
}


constexpr int RCOLS = 80;
__device__ __forceinline__ void ph_router_mfma(const int tid_, const int bid_, const float* h_gen, const float* W2_gen, const float* bg, const float* br,
                                               int* eidx, float* gate, float* rsbuf, int* cnt, unsigned char* lds) {
    const GAS float* h = (const GAS float*)h_gen;

    typedef float f32x4 __attribute__((ext_vector_type(4)));
    const int lane = tid_ & 63, wv = tid_ >> 6, li = lane & 15, lq = lane >> 4, kq8 = wv;
    float* part = (float*)lds;
    float* ssp = (float*)(lds + 8 * 32 * RCOLS * 4);
    const int t0 = bid_ * 32;
    typedef short bf16x8 __attribute__((ext_vector_type(8)));
    const GAS float* hp = h + (size_t)(t0 + li) * D + 256 * kq8 + 8 * lq;
    const GAS bf16_t* wp = (const GAS bf16_t*)W2_gen + (size_t)kq8 * 8 * 5 * 2 * 64 * 8 + lane * 8;
    f32x4 acc[2][5];
#pragma unroll
    for (int tt = 0; tt < 2; ++tt)
#pragma unroll
        for (int nb = 0; nb < 5; ++nb) acc[tt][nb] = (f32x4){0.f, 0.f, 0.f, 0.f};
    float ss[2] = {0.f, 0.f};
#pragma unroll 2
    for (int s = 0; s < 8; ++s) {
        f32x4 a0[2], a1[2];
#pragma unroll
        for (int tt = 0; tt < 2; ++tt) { a0[tt] = *(const GAS f32x4*)(hp + (size_t)(16 * tt) * D + 32 * s); a1[tt] = *(const GAS f32x4*)(hp + (size_t)(16 * tt) * D + 32 * s + 4); }
        bf16x8 bw[5][2];
#pragma unroll
        for (int nb = 0; nb < 5; ++nb)
#pragma unroll
            for (int hl = 0; hl < 2; ++hl) bw[nb][hl] = *(const GAS bf16x8*)(wp + (size_t)((s * 5 + nb) * 2 + hl) * 512);
#pragma unroll
        for (int tt = 0; tt < 2; ++tt) {
            const float av[8] = {a0[tt][0], a0[tt][1], a0[tt][2], a0[tt][3], a1[tt][0], a1[tt][1], a1[tt][2], a1[tt][3]};
            unsigned hi[4], lo[4];
#pragma unroll
            for (int e = 0; e < 4; ++e) {
                const float x0 = av[2 * e], x1 = av[2 * e + 1];
                ss[tt] += x0 * x0 + x1 * x1;
                const unsigned h0 = f2bf(x0), h1 = f2bf(x1);
                hi[e] = h0 | (h1 << 16);
                lo[e] = pk2(x0 - __builtin_bit_cast(float, h0 << 16), x1 - __builtin_bit_cast(float, h1 << 16));
            }
            const uint4 hw = make_uint4(hi[0], hi[1], hi[2], hi[3]), lw = make_uint4(lo[0], lo[1], lo[2], lo[3]);
            const bf16x8 ah = __builtin_bit_cast(bf16x8, hw), al = __builtin_bit_cast(bf16x8, lw);
#pragma unroll
            for (int nb = 0; nb < 5; ++nb) {
                acc[tt][nb] = __builtin_amdgcn_mfma_f32_16x16x32_bf16(ah, bw[nb][0], acc[tt][nb], 0, 0, 0);
                acc[tt][nb] = __builtin_amdgcn_mfma_f32_16x16x32_bf16(al, bw[nb][0], acc[tt][nb], 0, 0, 0);
                acc[tt][nb] = __builtin_amdgcn_mfma_f32_16x16x32_bf16(ah, bw[nb][1], acc[tt][nb], 0, 0, 0);
            }
        }
    }
#pragma unroll
    for (int tt = 0; tt < 2; ++tt) {
        float sv = ss[tt];
        sv += shflx(sv, 16, lane); sv += shflx(sv, 32, lane);
        if (lq == 0) ssp[kq8 * 32 + 16 * tt + li] = sv;
#pragma unroll
        for (int nb = 0; nb < 5; ++nb)
#pragma unroll
            for (int r = 0; r < 4; ++r) part[(kq8 * 32 + 16 * tt + 4 * lq + r) * RCOLS + 16 * nb + li] = acc[tt][nb][r];
    }
    __syncthreads();
    float* lgs = (float*)(lds + 8 * 32 * RCOLS * 4 + 1024);
    for (int i = tid_; i < 32 * RCOLS; i += NTHR) {
        const int tk32 = i / RCOLS, c = i % RCOLS;
        float sst = 0.f, v = 0.f;
#pragma unroll
        for (int kq = 0; kq < 8; ++kq) { sst += ssp[kq * 32 + tk32]; v += part[(kq * 32 + tk32) * RCOLS + c]; }
        const float rs = __builtin_amdgcn_rsqf(sst / (float)D + EPS);
        float bias = 0.f;
        if (c < 64) bias = br[c]; else if (c < 72) bias = bg[c - 64];
        lgs[i] = v * rs + bias;
        if (c == 0) rsbuf[bid_ * 32 + tk32] = rs;
    }
    __syncthreads();
    if (tid_ < 32) {
        const int t = bid_ * 32 + tid_;
        const float* lg = lgs + tid_ * RCOLS;
        int gi = 0; float mx = lg[64];
        for (int i = 1; i < 8; ++i) { const float v = lg[64 + i]; if (v > mx) { mx = v; gi = i; } }
        float sum = 0.f;
        for (int i = 0; i < 8; ++i) sum += expf(lg[64 + i] - mx);
        const float gp = 1.f / sum;
        const float* e8 = lg + gi * 8;
        int i1 = 0; float v1 = e8[0];
        for (int i = 1; i < 8; ++i) { const float v = e8[i]; if (v > v1) { v1 = v; i1 = i; } }
        int i2 = 0; float v2 = -INFINITY;
        for (int i = 0; i < 8; ++i) { const float v = e8[i]; if (i != i1 && v > v2) { v2 = v; i2 = i; } }
        const float e2 = expf(v2 - v1);
        const float a1 = 1.f / (1.f + e2), a2 = e2 / (1.f + e2);
        eidx[t * 2] = gi * 8 + i1; eidx[t * 2 + 1] = gi * 8 + i2;
        gate[t * 2] = a1 * gp; gate[t * 2 + 1] = a2 * gp;
        atomicAdd(&cnt[gi * 8 + i1], 1); atomicAdd(&cnt[gi * 8 + i2], 1);
    }
    __syncthreads();
}
__device__ __forceinline__ void ph_moe_scatter(const int tid_, const int bid_, const int* eidx, const float* gate, const int* cnt, int* cursor,
                                               const float* h, const float* rsbuf, const float* gn, bf16_t* Ag, float* slot_gate, int* tok_slot, int* ps, int* lte) {
    if (tid_ == 0) {
        int acc = 0;
        for (int e = 0; e < NE; ++e) { ps[e] = acc; acc += ((cnt[e] + MT - 1) / MT) * MT; }
        ps[NE] = acc;
    }
    __syncthreads();
    for (int i = tid_; i < NTILE; i += NTHR) {
        const int r = i * MT; int e = 0;
        if (r < ps[NE]) { for (int k = 0; k < NE; ++k) if (r >= ps[k] && r < ps[k + 1]) e = k; }
        lte[i] = e;
    }
    if (tid_ == 0) lte[NTILE] = ps[NE] / MT;
    const int lane = tid_ & 63, wv = tid_ >> 6, gw = bid_ * 8 + wv;
    int myslot = 0;
    if (lane < 8) { const int a = gw + NBLK * 8 * lane; const int e = eidx[a]; myslot = ps[e] + atomicAdd(&cursor[e], 1); tok_slot[a] = myslot; slot_gate[myslot] = gate[a]; }
    float4 gq0[4], gq1[4];
#pragma unroll
    for (int jj = 0; jj < 4; ++jj) { const int c = jj * 512 + lane * 8; gq0[jj] = ldgf4((const GAS void*)((const GAS float*)gn + c)); gq1[jj] = ldgf4((const GAS void*)((const GAS float*)gn + c + 4)); }
#pragma unroll 2
    for (int j = 0; j < 8; ++j) {
        const int a = gw + NBLK * 8 * j;
        const int slot = __builtin_amdgcn_readlane(myslot, j);
        const int tok = a >> 1;
        const float rs = rsbuf[tok];
        const GAS float* src = (const GAS float*)h + (size_t)tok * D;
        GAS bf16_t* dst = (GAS bf16_t*)Ag + (size_t)slot * D;
#pragma unroll
        for (int jj = 0; jj < 4; ++jj) {
            const int c = jj * 512 + lane * 8;
            const float4 v0 = ldgf4((const GAS void*)(src + c)), v1 = ldgf4((const GAS void*)(src + c + 4));
            const float4 g0 = gq0[jj], g1 = gq1[jj];
            stg16((GAS void*)(dst + c), make_uint4(pk2(v0.x * rs * g0.x, v0.y * rs * g0.y), pk2(v0.z * rs * g0.z, v0.w * rs * g0.w),
                                                   pk2(v1.x * rs * g1.x, v1.y * rs * g1.y), pk2(v1.z * rs * g1.z, v1.w * rs * g1.w)));
        }
    }
}
__device__ __forceinline__ void ph_moe_combine_norm(const int tid_, const int bid_, float* h_gen, const bf16_t* Yb_gen, const int* tok_slot, const float* g_gen, bf16_t* hnb_gen) {
    GAS float* h = (GAS float*)h_gen; const GAS bf16_t* Yb = (const GAS bf16_t*)Yb_gen; const GAS float* g = (const GAS float*)g_gen; GAS bf16_t* hnb = (GAS bf16_t*)hnb_gen;
    const int lane = tid_ & 63, wv = tid_ >> 6;
    int myslots = 0;
    if (lane < 8) myslots = tok_slot[(bid_ * 8 + wv + NBLK * 8 * (lane >> 1)) * 2 + (lane & 1)];
    float4 gq[8];
#pragma unroll
    for (int j = 0; j < 8; ++j) gq[j] = ldgf4((const GAS void*)(g + (lane + 64 * j) * 4));
#pragma unroll 4
    for (int j = 0; j < 4; ++j) {
        const int t = bid_ * 8 + wv + NBLK * 8 * j;
        const int s0 = __builtin_amdgcn_readlane(myslots, 2 * j), s1 = __builtin_amdgcn_readlane(myslots, 2 * j + 1);
        float4 hv[8]; float ss = 0.f;
#pragma unroll
        for (int j = 0; j < 8; ++j) {
            const int c = (lane + 64 * j) * 4;
            hv[j] = ldgf4((const GAS void*)(h + (size_t)t * D + c));
            const uint2 a = ldg8((const GAS void*)(Yb + (size_t)s0 * D + c)), b = ldg8((const GAS void*)(Yb + (size_t)s1 * D + c));
            hv[j].x += __builtin_bit_cast(float, a.x << 16) + __builtin_bit_cast(float, b.x << 16);
            hv[j].y += __builtin_bit_cast(float, a.x & 0xffff0000u) + __builtin_bit_cast(float, b.x & 0xffff0000u);
            hv[j].z += __builtin_bit_cast(float, a.y << 16) + __builtin_bit_cast(float, b.y << 16);
            hv[j].w += __builtin_bit_cast(float, a.y & 0xffff0000u) + __builtin_bit_cast(float, b.y & 0xffff0000u);
            ss += hv[j].x * hv[j].x + hv[j].y * hv[j].y + hv[j].z * hv[j].z + hv[j].w * hv[j].w;
            { f32x4_t w_; w_.x = hv[j].x; w_.y = hv[j].y; w_.z = hv[j].z; w_.w = hv[j].w; *(GAS f32x4_t*)(h + (size_t)t * D + c) = w_; }
        }
#pragma unroll
        for (int o = 32; o > 0; o >>= 1) ss += shflx(ss, o, lane);
        const float rs = __builtin_amdgcn_rsqf(ss * (1.0f / (float)D) + EPS);
#pragma unroll
        for (int j = 0; j < 8; ++j) {
            const int c = (lane + 64 * j) * 4;
            const float4 gv = gq[j];
            stg8((GAS void*)(hnb + (size_t)t * D + c), make_uint2(pk2(hv[j].x * rs * gv.x, hv[j].y * rs * gv.y), pk2(hv[j].z * rs * gv.z, hv[j].w * rs * gv.w)));
        }
    }
}
__device__ __forceinline__ void ph_init_rows(const int tid_, const int bid_, const float* x, const float* g, float* h, bf16_t* hb, float* ss) {
    const int lane = tid_ & 63, wv = tid_ >> 6;
    for (int t = bid_ * 8 + wv; t < T; t += NBLK * 8) {
        float sq = 0.f;
#pragma unroll
        for (int j = 0; j < 8; ++j) {
            const int c = (lane + 64 * j) * 4;
            const float4 v = *(const float4*)(x + (size_t)t * D + c);
            const float4 gv = *(const float4*)(g + c);
            *(float4*)(h + (size_t)t * D + c) = v;
            *(uint2*)(hb + (size_t)t * D + c) = make_uint2(pk2(v.x * gv.x, v.y * gv.y), pk2(v.z * gv.z, v.w * gv.w));
            sq += v.x * v.x + v.y * v.y + v.z * v.z + v.w * v.w;
        }
#pragma unroll
        for (int o = 32; o > 0; o >>= 1) sq += shflx(sq, o, lane);
        if (lane == 0) ss[t] = sq;
    }
}
__device__ __forceinline__ void ph_final_norm(const int tid_, const int bid_, const float* h, const float* ss, const float* g, float* out) {
    for (long i = GTID(); i < (long)T * D / 4; i += GSTRIDE()) {
        const int t = (int)(i / (D / 4)), c = (int)(i % (D / 4)) * 4;
        const float rs = __builtin_amdgcn_rsqf(ss[t] * (1.0f / (float)D) + EPS);
        const float4 v = ((const float4*)h)[i]; const float4 gv = *(const float4*)(g + c);
        ((float4*)out)[i] = make_float4(v.x * rs * gv.x, v.y * rs * gv.y, v.z * rs * gv.z, v.w * rs * gv.w);
    }
}

#define EPI_DECODE() unsigned ez_ = 0u; asm volatile("" : "+s"(ez_)); int ew_ = wave_s; asm volatile("" : "+s"(ew_)); \
    const int el_ = (int)__builtin_amdgcn_mbcnt_hi(~0u, __builtin_amdgcn_mbcnt_lo(~0u, ez_)); \
    const int wr = ew_ >> 2, wc = ew_ & 3, fr = el_ & 15, fq = el_ >> 4;

struct EpiPle {
    static constexpr bool PERM = false, AFTER_DRAIN = false;
    float* H; const bf16_t* aux; const float* gnext; bf16_t* hb; float* ssn; int wave_s;
    __device__ __forceinline__ void operator()(const pg8::f32x4 (&acc)[2][2][4][2], const pg8::Unit& u, int, int, int, int) const {
        EPI_DECODE();
        const int row0 = u.pm * 256 + wr * 64 + fr, col0 = u.pn * 256 + wc * 32 + fq * 4;
        pg8::f32x4 gnv[2][2];
#pragma unroll
        for (int bj = 0; bj < 2; ++bj)
#pragma unroll
            for (int n = 0; n < 2; ++n) gnv[bj][n] = *(const GAS pg8::f32x4*)(gnext + col0 + bj * 128 + n * 16);
#pragma unroll
        for (int ai = 0; ai < 2; ++ai)
#pragma unroll
            for (int m = 0; m < 4; ++m) {
                const size_t row = (size_t)(row0 + ai * 128 + m * 16);
                float sq = 0.f;
                unsigned hw[2][2][2];
#pragma unroll
                for (int bj = 0; bj < 2; ++bj)
#pragma unroll
                    for (int n = 0; n < 2; ++n) {
                        const int col = col0 + bj * 128 + n * 16;
                        const pg8::f32x4 v = acc[ai][bj][m][n];
                        GAS pg8::f32x4* p = (GAS pg8::f32x4*)(H + row * D + col);
                        const uint2 ab = ldg8((const GAS void*)(aux + row * D + col));
                        const float a[4] = {__uint_as_float(ab.x << 16), __uint_as_float(ab.x & 0xffff0000u), __uint_as_float(ab.y << 16), __uint_as_float(ab.y & 0xffff0000u)};
                        const pg8::f32x4 gn = gnv[bj][n];
                        pg8::f32x4 o = *p;
#pragma unroll
                        for (int e = 0; e < 4; ++e) { o[e] += a[e] * __builtin_amdgcn_rcpf(1.f + __expf(-v[e])); sq += o[e] * o[e]; }
                        *p = o;
                        hw[bj][n][0] = pk2(o[0] * gn[0], o[1] * gn[1]); hw[bj][n][1] = pk2(o[2] * gn[2], o[3] * gn[3]);
                    }
#pragma unroll
                for (int bj = 0; bj < 2; ++bj)
                    pair_store_bf16((GAS bf16_t*)hb + row * D + (u.pn * 256 + wc * 32 + bj * 128), 0, 16, hw[bj][0][0], hw[bj][0][1], hw[bj][1][0], hw[bj][1][1], fq);
                sq += shflx(sq, 16, el_); sq += shflx(sq, 32, el_);
                if (fq == 0) (void)__hip_atomic_fetch_add((GAS float*)ssn + row, sq, __ATOMIC_RELAXED, __HIP_MEMORY_SCOPE_AGENT);
            }
    }
};


struct EpiZ {
    static constexpr bool PERM = true, AFTER_DRAIN = false;
    bf16_t* Z; int ldz; int nvalid; const float* ss; int wave_s;
    __device__ __forceinline__ void operator()(const pg8::f32x4 (&acc)[2][2][4][2], const pg8::Unit& u, int, int, int, int) const {
        EPI_DECODE();
        const int row0 = u.pm * 256 + wr * 64 + fr, col0 = u.pn * 256 + wc * 32 + 8 * fq;
#pragma unroll
        for (int ai = 0; ai < 2; ++ai)
#pragma unroll
            for (int m = 0; m < 4; ++m) {
                const size_t row = (size_t)(row0 + ai * 128 + m * 16);
                const float rs = __builtin_amdgcn_rsqf(((const GAS float*)ss)[row] * (1.0f / (float)D) + EPS);
#pragma unroll
                for (int bj = 0; bj < 2; ++bj) {
                    const int col = col0 + bj * 128;
                    if (col < nvalid) {
                        const pg8::f32x4 v0 = acc[ai][bj][m][0] * rs, v1 = acc[ai][bj][m][1] * rs;
                        stg16((GAS void*)(Z + row * ldz + col), make_uint4(pk2(v0[0], v0[1]), pk2(v0[2], v0[3]), pk2(v1[0], v1[1]), pk2(v1[2], v1[3])));
                    }
                }
            }
    }
};
struct EpiB16S {
    static constexpr bool PERM = true, AFTER_DRAIN = false;
    bf16_t* O; int ldo; int nvalid; const float* rsrow; const float* rscol; float cs; int wave_s;
    __device__ __forceinline__ void operator()(const pg8::f32x4 (&acc)[2][2][4][2], const pg8::Unit& u, int, int, int, int) const {
        EPI_DECODE();
        const int row0 = u.pm * 256 + wr * 64 + fr, col0 = u.pn * 256 + wc * 32 + 8 * fq;
#pragma unroll
        for (int bj = 0; bj < 2; ++bj) {
            const int col = col0 + bj * 128;
            if (col < nvalid) {
                pg8::f32x4 c0 = (pg8::f32x4){cs, cs, cs, cs}, c1 = c0;
                if (rscol) { c0 = c0 * *(const GAS pg8::f32x4*)(rscol + col); c1 = c1 * *(const GAS pg8::f32x4*)(rscol + col + 4); }
#pragma unroll
                for (int ai = 0; ai < 2; ++ai)
#pragma unroll
                    for (int m = 0; m < 4; ++m) {
                        const size_t row = (size_t)(row0 + ai * 128 + m * 16);
                        const float rr = rsrow ? ((const GAS float*)rsrow)[row] : 1.f;
                        const pg8::f32x4 v0 = acc[ai][bj][m][0] * c0 * rr, v1 = acc[ai][bj][m][1] * c1 * rr;
                        stg16((GAS void*)(O + row * ldo + col), make_uint4(pk2(v0[0], v0[1]), pk2(v0[2], v0[3]), pk2(v1[0], v1[1]), pk2(v1[2], v1[3])));
                    }
            }
        }
    }
};

__device__ __forceinline__ void unpack8(const uint4 w, float (&f)[8]) {
    f[0] = BFLO(w.x); f[1] = BFHI(w.x); f[2] = BFLO(w.y); f[3] = BFHI(w.y); f[4] = BFLO(w.z); f[5] = BFHI(w.z); f[6] = BFLO(w.w); f[7] = BFHI(w.w);
}
__device__ __forceinline__ uint4 pack8(const float (&f)[8]) { return make_uint4(pk2(f[0], f[1]), pk2(f[2], f[3]), pk2(f[4], f[5]), pk2(f[6], f[7])); }
__device__ __forceinline__ void ph_light(const int tid_, const int bid_, bf16_t* zb_gen, const float* cw_gen, const float* cd_gen, const float* sd_gen, const float* cm_gen, const float* sm_gen,
                                         bf16_t* mixb_gen, float* rsq, float* rskv) {
    GAS bf16_t* zb = (GAS bf16_t*)zb_gen; GAS bf16_t* mixb = (GAS bf16_t*)mixb_gen;
    const GAS float* cw = (const GAS float*)cw_gen; const GAS float* cd = (const GAS float*)cd_gen; const GAS float* sd = (const GAS float*)sd_gen;
    const GAS float* cm = (const GAS float*)cm_gen; const GAS float* sm = (const GAS float*)sm_gen;
    const float QS = 0.125f * 1.4426950408889634f;
    const int lane = tid_ & 63, wv = tid_ >> 6;
    for (int t = bid_ * 8 + wv; t < T; t += NBLK * 8) {
        GAS bf16_t* zr = zb + (size_t)t * DIN;
        const int spos = t % S;
        if (lane < 56) {
            const int c = lane * 8;
            float cb[8], a0[8], b0[8], y[8], w0[8], w1[8], w2[8];
            unpack8(ldg16((const GAS void*)(zr + OFF_CB + c)), cb); unpack8(ldg16((const GAS void*)(zr + OFF_CC + c)), a0); unpack8(ldg16((const GAS void*)(zr + OFF_CH + c)), b0);
#pragma unroll
            for (int e = 0; e < 8; ++e) { w0[e] = cw[c + e]; w1[e] = cw[CONVD + c + e]; w2[e] = cw[2 * CONVD + c + e]; y[e] = w2[e] * a0[e] * b0[e]; }
            if (spos >= 1) { float a1[8], b1[8]; unpack8(ldg16((const GAS void*)(zr - DIN + OFF_CC + c)), a1); unpack8(ldg16((const GAS void*)(zr - DIN + OFF_CH + c)), b1);
#pragma unroll
                for (int e = 0; e < 8; ++e) y[e] += w1[e] * a1[e] * b1[e]; }
            if (spos >= 2) { float a2[8], b2[8]; unpack8(ldg16((const GAS void*)(zr - 2 * DIN + OFF_CC + c)), a2); unpack8(ldg16((const GAS void*)(zr - 2 * DIN + OFF_CH + c)), b2);
#pragma unroll
                for (int e = 0; e < 8; ++e) y[e] += w0[e] * a2[e] * b2[e]; }
#pragma unroll
            for (int e = 0; e < 8; ++e) y[e] *= cb[e];
            stg16((GAS void*)(mixb + (size_t)t * D + c), pack8(y));
        }
        if (lane < 18) {
            const int isk = lane / 9, head = lane % 9;
            GAS bf16_t* p = zr + (isk ? OFF_DK : OFF_DQ) + head * 64;
            float x1[8], x2[8], o1[8], o2[8];
            unpack8(ldg16((const GAS void*)p), x1); unpack8(ldg16((const GAS void*)(p + 8)), x2);
            const float sc = isk ? 1.f : QS;
#pragma unroll
            for (int e = 0; e < 8; ++e) { const float c = cd[t * 8 + e], sn = sd[t * 8 + e]; o1[e] = (x1[e] * c - x2[e] * sn) * sc; o2[e] = (x2[e] * c + x1[e] * sn) * sc; }
            stg16((GAS void*)p, pack8(o1)); stg16((GAS void*)(p + 8), pack8(o2));
        }
        if (lane < 54) {
            const int head = lane / 6, ch = 2 + lane % 6;
            GAS bf16_t* p = zr + OFF_DQ + head * 64 + ch * 8;
            float x[8]; unpack8(ldg16((const GAS void*)p), x);
#pragma unroll
            for (int e = 0; e < 8; ++e) x[e] *= QS;
            stg16((GAS void*)p, pack8(x));
        }
        if (lane < 2) {
            GAS bf16_t* p = zr + OFF_KR + 8 * lane;
            float x1[8], x2[8], o1[8], o2[8];
            unpack8(ldg16((const GAS void*)p), x1); unpack8(ldg16((const GAS void*)(p + 16)), x2);
#pragma unroll
            for (int e = 0; e < 8; ++e) { const float c = cm[t * 16 + 8 * lane + e], sn = sm[t * 16 + 8 * lane + e]; o1[e] = x1[e] * c - x2[e] * sn; o2[e] = x2[e] * c + x1[e] * sn; }
            stg16((GAS void*)p, pack8(o1)); stg16((GAS void*)(p + 16), pack8(o2));
        }
        float sq = 0.f, sk = 0.f;
        if (lane < 48) { float x[8]; unpack8(ldg16((const GAS void*)(zr + OFF_CQ + 8 * lane)), x);
#pragma unroll
            for (int e = 0; e < 8; ++e) sq += x[e] * x[e]; }
        if (lane < 32) { float x[8]; unpack8(ldg16((const GAS void*)(zr + OFF_CKV + 8 * lane)), x);
#pragma unroll
            for (int e = 0; e < 8; ++e) sk += x[e] * x[e]; }
#pragma unroll
        for (int o = 32; o > 0; o >>= 1) { sq += shflx(sq, o, lane); sk += shflx(sk, o, lane); }
        if (lane == 0) { rsq[t] = __builtin_amdgcn_rsqf(sq * (1.0f / (float)QR) + EPS); rskv[t] = __builtin_amdgcn_rsqf(sk * (1.0f / (float)KVR) + EPS); }
    }
}


constexpr int MG_A_BYTES = MT * 128, MG_B_BYTES = 128 * 128;
constexpr int MG_MF = MT / 64;
template <int MODE>
__device__ __forceinline__ void moe_gemm(const int tid_in, const int bid_, const LAS int* lte, const bf16_t* A, const int, const int,
                                         const float* W0, const float* W1, bf16_t* out, const float* slot_gate, PG8_LAS unsigned char* lds) {
    using namespace pg8;
    typedef unsigned u32x2_ __attribute__((ext_vector_type(2)));
    typedef float f32x2_ __attribute__((ext_vector_type(2)));
    constexpr int NPN = (MODE == 1) ? 8 : 16;
    constexpr int LDW = (MODE == 1) ? FF : D;
    constexpr int lda = (MODE == 1) ? D : FF, K = lda;
    const int tid = tid_in, wid = __builtin_amdgcn_readfirstlane(tid >> 6), lane = tid & 63, wr = wid >> 1, wc = wid & 1, fr = lane & 15, fq = lane >> 4;
    const int ntl = lte[NTILE], nt = K / 64;
    const int arow = tid >> 3, akc = tid & 7;
    const int aoff_w = arow * 128 + ((akc ^ (arow & 7)) << 4);
    const int np = lane;
    const int boff_w0 = (2 * np) * 128 + ((wid ^ ((2 * np) & 7)) << 4), boff_w1 = (2 * np + 1) * 128 + ((wid ^ ((2 * np + 1) & 7)) << 4);
    const int sw0 = ((fq) ^ (fr & 7)) << 4, sw1 = ((4 + fq) ^ (fr & 7)) << 4;
    const int aoff_r = (80 * wr + fr) * 128;
    const int boff_r = (MODE == 1) ? (32 * wc + fr) * 128 : (64 * wc + fr) * 128;
    PG8_LAS unsigned char* ldsB = lds + 2 * MG_A_BYTES;
    const int nunits_p = ((ntl + 7) >> 3) * 8 * NPN;
    for (int q = bid_; q < nunits_p; q += NBLK) {
        const int grp = q / (8 * NPN), rr = q % (8 * NPN), pl = rr >> 3, mt = grp * 8 + (rr & 7);
        if (mt >= ntl) continue;
        const int e = lte[mt];
        const int koff = (mt * 5) & (nt - 1);
        int zq = 0; asm volatile("" : "+v"(zq));
        const bf16_t* Aq = A; const float* W0q = W0; const float* W1q = W1; asm volatile("" : "+s"(Aq), "+s"(W0q), "+s"(W1q));
        const GAS bf16_t* asrc = (const GAS bf16_t*)(Aq + (size_t)(unsigned)(mt * MT + arow + zq) * lda + 8 * akc);
        const GAS float* wsrc;
        if (MODE == 1) wsrc = (const GAS float*)(((np >= 32) ? W1q : W0q) + (size_t)e * D * FF + 64 * pl + 2 * (np & 31) + zq + (size_t)(8 * wid) * LDW);
        else wsrc = (const GAS float*)(W0q + (size_t)e * FF * D + 128 * pl + 2 * np + zq + (size_t)(8 * wid) * LDW);
        f32x4 acc[MG_MF][4];
#pragma unroll
        for (int m = 0; m < MG_MF; ++m)
#pragma unroll
            for (int n = 0; n < 4; ++n) acc[m][n] = (f32x4){0.f, 0.f, 0.f, 0.f};
        u32x4 ra[5]; f32x2_ rb0[8], rb1[8];
#define MG_LOADA(kt) do { const int kk_ = ((kt) + koff) & (nt - 1); \
            _Pragma("unroll") for (int i_ = 0; i_ < 5; ++i_) ra[i_] = *(const GAS u32x4*)(asrc + (size_t)(64 * i_) * lda + kk_ * 64); } while (0)
#define MG_LOADB(rb, kt) do { const int kk_ = ((kt) + koff) & (nt - 1); \
            _Pragma("unroll") for (int i_ = 0; i_ < 8; ++i_) rb[i_] = __builtin_nontemporal_load((const GAS f32x2_*)(wsrc + (size_t)(kk_ * 64 + i_) * LDW)); } while (0)
#define MG_WRITE(rb, st) do { PG8_LAS unsigned char* aw_ = lds + (st) * MG_A_BYTES + aoff_w; PG8_LAS unsigned char* bw_ = ldsB + (st) * MG_B_BYTES; \
            _Pragma("unroll") for (int i_ = 0; i_ < 5; ++i_) *(PG8_LAS u32x4*)(aw_ + i_ * 64 * 128) = ra[i_]; \
            u32x4 w0_, w1_; \
            w0_.x = cvt_pk_bf16(rb[0][0], rb[1][0]); w0_.y = cvt_pk_bf16(rb[2][0], rb[3][0]); w0_.z = cvt_pk_bf16(rb[4][0], rb[5][0]); w0_.w = cvt_pk_bf16(rb[6][0], rb[7][0]); \
            w1_.x = cvt_pk_bf16(rb[0][1], rb[1][1]); w1_.y = cvt_pk_bf16(rb[2][1], rb[3][1]); w1_.z = cvt_pk_bf16(rb[4][1], rb[5][1]); w1_.w = cvt_pk_bf16(rb[6][1], rb[7][1]); \
            *(PG8_LAS u32x4*)(bw_ + boff_w0) = w0_; *(PG8_LAS u32x4*)(bw_ + boff_w1) = w1_; } while (0)
#define MG_RDA(dst, st, m, swk) do { dst = *(const PG8_LAS bf16x8*)(lds + (st) * MG_A_BYTES + aoff_r + (m) * 16 * 128 + swk); } while (0)
#define MG_MM(m, Af) do { __builtin_amdgcn_s_setprio(1); _Pragma("unroll") for (int n = 0; n < 4; ++n) acc[m][n] = __builtin_amdgcn_mfma_f32_16x16x32_bf16(Bf[n], Af, acc[m][n], 0, 0, 0); __builtin_amdgcn_s_setprio(0); } while (0)
#define MG_HALF(st, swk) do { bf16x8 Bf[4], Aa, Ab; \
            _Pragma("unroll") for (int n = 0; n < 4; ++n) { const int ro_ = (MODE == 1) ? ((n & 1) * 16 + (n >> 1) * 64) * 128 : n * 16 * 128; \
                Bf[n] = *(const PG8_LAS bf16x8*)(ldsB + (st) * MG_B_BYTES + boff_r + ro_ + swk); } \
            MG_RDA(Aa, st, 0, swk); MG_RDA(Ab, st, 1, swk); \
            MG_MM(0, Aa); MG_RDA(Aa, st, 2, swk); \
            MG_MM(1, Ab); MG_RDA(Ab, st, 3, swk); \
            MG_MM(2, Aa); MG_RDA(Aa, st, 4, swk); \
            MG_MM(3, Ab); \
            MG_MM(4, Aa); } while (0)
#define MG_COMPUTE(st) do { MG_HALF(st, sw0); MG_HALF(st, sw1); } while (0)
        MG_LOADA(0); MG_LOADB(rb0, 0); MG_LOADB(rb1, 1);
        MG_WRITE(rb0, 0);
        MG_LOADA(1);
        __syncthreads();
        for (int t = 0; t < nt; t += 2) {
            MG_LOADB(rb0, t + 2);
            MG_COMPUTE(0);
            MG_WRITE(rb1, 1);
            MG_LOADA(t + 2);
            __syncthreads();
            MG_LOADB(rb1, t + 3);
            MG_COMPUTE(1);
            MG_WRITE(rb0, 0);
            MG_LOADA(t + 3);
            __syncthreads();
        }
        int ze = 0; asm volatile("" : "+v"(ze));
        bf16_t* outq = out; const float* sgq = slot_gate; asm volatile("" : "+s"(outq), "+s"(sgq));
#pragma unroll
        for (int m = 0; m < MG_MF; ++m) {
            const size_t row = (size_t)(unsigned)(mt * MT + 80 * wr + m * 16 + fr + ze);
#define MG_PAIR_STORE(base_, a0_, a1_, b0_, b1_, c0_, c1_) do { \
                const auto rx_ = __builtin_amdgcn_permlane16_swap((a0_), (b0_), false, false); const unsigned x0_ = rx_[0], x1_ = rx_[1]; \
                const auto ry_ = __builtin_amdgcn_permlane16_swap((a1_), (b1_), false, false); const unsigned y0_ = ry_[0], y1_ = ry_[1]; \
                u32x4 w4_; w4_.x = x0_; w4_.y = y0_; w4_.z = x1_; w4_.w = y1_; \
                *(GAS u32x4*)((base_) + ((fq & 1) ? (c1_) : (c0_)) + 8 * (fq >> 1)) = w4_; } while (0)
            if (MODE == 1) {
                unsigned pw[2][2];
#pragma unroll
                for (int n = 0; n < 2; ++n) {
                    const f32x4 g = acc[m][n], up = acc[m][n + 2];
                    float o[4];
#pragma unroll
                    for (int e2 = 0; e2 < 4; ++e2) o[e2] = (g[e2] * __builtin_amdgcn_rcpf(1.f + __expf(-g[e2]))) * up[e2];
                    pw[n][0] = pk2(o[0], o[1]); pw[n][1] = pk2(o[2], o[3]);
                }
                MG_PAIR_STORE(outq + row * FF + 64 * pl + 32 * wc, pw[0][0], pw[0][1], pw[1][0], pw[1][1], 0, 16);
            } else {
                const float gt = *(const GAS float*)(sgq + row);
                unsigned pw[4][2];
#pragma unroll
                for (int n = 0; n < 4; ++n) { const f32x4 v = acc[m][n] * gt; pw[n][0] = pk2(v[0], v[1]); pw[n][1] = pk2(v[2], v[3]); }
                MG_PAIR_STORE(outq + row * D + 128 * pl + 64 * wc, pw[0][0], pw[0][1], pw[1][0], pw[1][1], 0, 16);
                MG_PAIR_STORE(outq + row * D + 128 * pl + 64 * wc, pw[2][0], pw[2][1], pw[3][0], pw[3][1], 32, 48);
            }
#undef MG_PAIR_STORE
        }
    }
#undef MG_LOADA
#undef MG_LOADB
#undef MG_WRITE
#undef MG_COMPUTE
#undef MG_RDA
#undef MG_MM
#undef MG_HALF
}

__device__ __forceinline__ void ph_thin_win(const int tid_, const int bid_, const bf16_t* hb_gen, const bf16_t* WinT_gen, const float* ss, bf16_t* zb_gen, unsigned char* lds) {
    const GAS bf16_t* hb = (const GAS bf16_t*)hb_gen;
    const GAS bf16_t* WinT = (const GAS bf16_t*)WinT_gen;
    GAS bf16_t* zb = (GAS bf16_t*)zb_gen;

    typedef short bf16x8 __attribute__((ext_vector_type(8)));
    typedef float f32x16 __attribute__((ext_vector_type(16)));
    const int lane = tid_ & 63, wv = tid_ >> 6, l31 = lane & 31, hh = lane >> 5;
    float* part = (float*)lds;
    f32x16 acc[3];
#pragma unroll
    for (int nt = 0; nt < 3; ++nt)
#pragma unroll
        for (int e = 0; e < 16; ++e) acc[nt][e] = 0.f;
    const GAS bf16_t* ap = hb + (size_t)(bid_ * 32 + l31) * D + 256 * wv + 8 * hh;
    const GAS bf16_t* bp = WinT + (size_t)(4096 + l31) * D + 256 * wv + 8 * hh;
#pragma unroll 4
    for (int ks = 0; ks < 16; ++ks) {
        const bf16x8 a = *(const GAS bf16x8*)(ap + 16 * ks);
#pragma unroll
        for (int nt = 0; nt < 3; ++nt) {
            const bf16x8 b = *(const GAS bf16x8*)(bp + (size_t)nt * 32 * D + 16 * ks);
            acc[nt] = __builtin_amdgcn_mfma_f32_32x32x16_bf16(a, b, acc[nt], 0, 0, 0);
        }
    }
#pragma unroll
    for (int nt = 0; nt < 3; ++nt)
#pragma unroll
        for (int e = 0; e < 16; ++e) {
            const int row = (e & 3) + 8 * (e >> 2) + 4 * hh;
            part[((wv * 3 + nt) * 32 + row) * 33 + l31] = acc[nt][e];
        }
    __syncthreads();
    {
        const int row = tid_ >> 4, cg = tid_ & 15;
        const size_t grow = (size_t)bid_ * 32 + row;
        const float rs = __builtin_amdgcn_rsqf(ss[grow] * (1.0f / (float)D) + EPS);
        float o[6];
#pragma unroll
        for (int c = 0; c < 6; ++c) {
            const int col = 6 * cg + c, nt = col >> 5, j = col & 31;
            float v = 0.f;
#pragma unroll
            for (int w = 0; w < 8; ++w) v += part[((w * 3 + nt) * 32 + row) * 33 + j];
            o[c] = v * rs;
        }
        GAS unsigned* dst = (GAS unsigned*)(zb + grow * DIN + 4096 + 6 * cg);
        dst[0] = pk2(o[0], o[1]); dst[1] = pk2(o[2], o[3]); dst[2] = pk2(o[4], o[5]);
    }
    __syncthreads();
}

struct MoeOrder {
    const LAS int* tile_e; int nunits, npn, c;
    __device__ __forceinline__ bool next(int i, pg8::Unit& u) const {
        const int q = i * NBLK + c; if (q >= nunits) return false;
        const int mt = q / npn, pl = q % npn; u.pm = mt; u.pn = tile_e[mt] * npn + pl; return true;
    }
    __device__ __forceinline__ void a_ready(const pg8::Unit&) const {}
    __device__ __forceinline__ void done(const pg8::Unit&) const {}
};
__device__ __forceinline__ void tr_reg(const float* W, int ldw, int k0, int n0, bf16_t* WT, size_t dstrow0, int Kpad, int lane, const float* gk = nullptr) {
    const int nq = lane >> 3, kc = lane & 7;
    const float* src = W + (size_t)(k0 + 8 * kc) * ldw + n0 + 4 * nq;
    pg8::f32x4 r[8];
#pragma unroll
    for (int i = 0; i < 8; ++i) { r[i] = *(const pg8::f32x4*)(src + (size_t)i * ldw); if (gk) r[i] = r[i] * gk[k0 + 8 * kc + i]; }
#pragma unroll
    for (int j = 0; j < 4; ++j)
        *(uint4*)(WT + (dstrow0 + 4 * nq + j) * Kpad + k0 + 8 * kc) = make_uint4(pk2(r[0][j], r[1][j]), pk2(r[2][j], r[3][j]), pk2(r[4][j], r[5][j]), pk2(r[6][j], r[7][j]));
}

template <int MODE> struct EpiG {
    static constexpr bool PERM = false, AFTER_DRAIN = false;
    float* C; int ldc; int nvalid; const float* aux; int ldaux; const float* bias; bf16_t* Cb; int ldcb; int wave_s;
    __device__ __forceinline__ void operator()(const pg8::f32x4 (&acc)[2][2][4][2], const pg8::Unit& u, int, int, int, int) const {
        EPI_DECODE();
        const int row0 = u.pm * 256 + wr * 64 + fr, col0 = u.pn * 256 + wc * 32 + fq * 4;
#pragma unroll
        for (int ai = 0; ai < 2; ++ai)
#pragma unroll
            for (int m = 0; m < 4; ++m) {
                const size_t row = (size_t)(row0 + ai * 128 + m * 16);
                if (MODE == 5) {
#pragma unroll
                    for (int bj = 0; bj < 2; ++bj) {
                        const pg8::f32x4 va = acc[ai][bj][m][0], vb = acc[ai][bj][m][1];
                        pair_store_bf16((GAS bf16_t*)Cb + row * ldcb + (u.pn * 256 + wc * 32 + bj * 128), 0, 16, pk2(va[0], va[1]), pk2(va[2], va[3]), pk2(vb[0], vb[1]), pk2(vb[2], vb[3]), fq);
                    }
                    continue;
                }
#pragma unroll
                for (int bj = 0; bj < 2; ++bj)
#pragma unroll
                    for (int n = 0; n < 2; ++n) {
                        const int col = col0 + bj * 128 + n * 16;
                        if (col < nvalid) {
                            const pg8::f32x4 v = acc[ai][bj][m][n];
                            if (MODE == 0) { *(GAS pg8::f32x4*)(C + row * ldc + col) = v; }
                            else if (MODE == 5) { stg8((GAS void*)(Cb + row * ldcb + col), make_uint2(pk2(v[0], v[1]), pk2(v[2], v[3]))); }
                            else if (MODE == 1) { GAS pg8::f32x4* p = (GAS pg8::f32x4*)(C + row * ldc + col); *p = *p + v; }
                            else if (MODE == 3) {
                                pg8::f32x4* p = (pg8::f32x4*)(C + row * ldc + col);
                                const pg8::f32x4 a = *(const pg8::f32x4*)(aux + row * ldaux + col);
                                pg8::f32x4 o = *p;
#pragma unroll
                                for (int e = 0; e < 4; ++e) o[e] += a[e] * __builtin_amdgcn_rcpf(1.f + __expf(-v[e]));
                                *p = o;
                            } else if (MODE == 4) {
                                const pg8::f32x4 a = *(const GAS pg8::f32x4*)(aux + row * ldaux + col);
                                const pg8::f32x4 b = *(const GAS pg8::f32x4*)(bias + col);
                                float o[4];
#pragma unroll
                                for (int e = 0; e < 4; ++e) o[e] = a[e] * __builtin_amdgcn_rcpf(1.f + __expf(-(v[e] + b[e])));
                                stg8((GAS void*)(Cb + row * ldcb + col), make_uint2(pk2(o[0], o[1]), pk2(o[2], o[3])));
                            }
                        }
                    }
            }
    }
};


constexpr int KNP = 576;
constexpr int AK_ROW = 104, AV_ROW = 72;
constexpr int AK_BYTES = 64 * AK_ROW * 2, AV_BYTES = 64 * AV_ROW * 2;
constexpr int AV2_ROW = 136;
constexpr int AK2_BYTES = 128 * AK_ROW * 2, AV2_BYTES = 64 * AV2_ROW * 2;
__device__ __forceinline__ void ph_mla_attn_mfma(const int tid_, const int bid_, const bf16_t* qfb_gen, const bf16_t* knb_gen, const bf16_t* zb_gen, const bf16_t* vTb_gen, bf16_t* mixb_gen,
                                                 const float* cm, const float* sm, unsigned char* lds) {
    const GAS bf16_t* qfb = (const GAS bf16_t*)qfb_gen;
    const GAS bf16_t* knb = (const GAS bf16_t*)knb_gen;
    const GAS bf16_t* zb = (const GAS bf16_t*)zb_gen;
    const GAS bf16_t* vTb = (const GAS bf16_t*)vTb_gen;
    GAS bf16_t* mixb = (GAS bf16_t*)mixb_gen;

    typedef short bf16x8 __attribute__((ext_vector_type(8)));
    typedef float f32x4 __attribute__((ext_vector_type(4)));
    const int lane = tid_ & 63, wv = tid_ >> 6, li = lane & 15, lq = lane >> 4, kg = wv >> 2, qg = wv & 3;
    float* mrg = (float*)(lds + 2 * AK2_BYTES + 2 * AV2_BYTES);
    for (int r = 0; r < 3; ++r) {
        const int idx = r * NBLK + ((r & 1) ? (NBLK - 1 - bid_) : bid_);
        if (idx >= 576) break;
        const int qb = 15 - idx / 36, bh = idx % 36, b = bh / 9, h = bh % 9;
        const int q0 = qb * 128, qw = q0 + qg * 32;
        const size_t tb = (size_t)b * S;
        bf16x8 qf[2][3];
#pragma unroll
        for (int qt = 0; qt < 2; ++qt) {
#pragma unroll
            for (int ks = 0; ks < 3; ++ks) qf[qt][ks] = *(const GAS bf16x8*)(qfb + (tb + qw + 16 * qt + li) * NQ + h * 96 + 32 * ks + 8 * lq);
            {
                const uint4 w = __builtin_bit_cast(uint4, qf[qt][2]);
                float f[8], pr[8], o8[8];
                unpack8(w, f);
#pragma unroll
                for (int e = 0; e < 8; ++e) pr[e] = shflx(f[e], 32, lane);
                const size_t tq_ = tb + qw + 16 * qt + li;
                const float4 c0 = *(const float4*)(cm + tq_ * 16 + 8 * (lq & 1)), c1 = *(const float4*)(cm + tq_ * 16 + 8 * (lq & 1) + 4);
                const float4 s0 = *(const float4*)(sm + tq_ * 16 + 8 * (lq & 1)), s1 = *(const float4*)(sm + tq_ * 16 + 8 * (lq & 1) + 4);
                const float cc[8] = {c0.x, c0.y, c0.z, c0.w, c1.x, c1.y, c1.z, c1.w}, sn[8] = {s0.x, s0.y, s0.z, s0.w, s1.x, s1.y, s1.z, s1.w};
                const float sg = (lq < 2) ? -1.f : 1.f;
#pragma unroll
                for (int e = 0; e < 8; ++e) o8[e] = f[e] * cc[e] + sg * pr[e] * sn[e];
                const uint4 wo = pack8(o8);
                qf[qt][2] = __builtin_bit_cast(bf16x8, wo);
            }
        }
        f32x4 o[2][4];
#pragma unroll
        for (int qt = 0; qt < 2; ++qt)
#pragma unroll
            for (int dt = 0; dt < 4; ++dt) o[qt][dt] = (f32x4){0.f, 0.f, 0.f, 0.f};
        float mrun[2] = {-1e30f, -1e30f}, lrun[2] = {0.f, 0.f};
        const int npair = qb + 1;
        uint4 rk[3], rv[2];
#define MLA_LOAD(pr_) do { const size_t t0_ = tb + (size_t)(pr_) * 128; \
            _Pragma("unroll") for (int j_ = 0; j_ < 3; ++j_) { const int c_ = tid_ + 512 * j_, key_ = c_ / 12, part_ = c_ - 12 * key_; \
                rk[j_] = (part_ < 8) ? ldg16((const GAS void*)(knb + (t0_ + key_) * KNP + h * 64 + 8 * part_)) : ldg16((const GAS void*)(zb + (t0_ + key_) * DIN + OFF_KR + 8 * (part_ - 8))); } \
            _Pragma("unroll") for (int j_ = 0; j_ < 2; ++j_) rv[j_] = ldg16((const GAS void*)(vTb + (size_t)(h * 64 + (tid_ >> 4) + 32 * j_) * T + t0_ + 8 * (tid_ & 15))); } while (0)
#define MLA_WRITE(buf) do { unsigned char* kb_ = lds + (buf) * AK2_BYTES; unsigned char* vb_ = lds + 2 * AK2_BYTES + (buf) * AV2_BYTES; \
            _Pragma("unroll") for (int j_ = 0; j_ < 3; ++j_) { const int c_ = tid_ + 512 * j_, key_ = c_ / 12, part_ = c_ - 12 * key_; *(uint4*)(kb_ + (key_ * AK_ROW + 8 * part_) * 2) = rk[j_]; } \
            _Pragma("unroll") for (int j_ = 0; j_ < 2; ++j_) *(uint4*)(vb_ + (((tid_ >> 4) + 32 * j_) * AV2_ROW + 8 * (tid_ & 15)) * 2) = rv[j_]; } while (0)
        MLA_LOAD(0);
        __syncthreads();
        MLA_WRITE(0);
        __syncthreads();
        for (int pr = 0; pr < npair; ++pr) {
            { const int nb_ = (pr + 1 < npair) ? (pr + 1) : pr; MLA_LOAD(nb_); }
            const int k0 = pr * 128 + kg * 64;
            if (k0 <= qw + 31) {
                const unsigned char* kt = lds + (pr & 1) * AK2_BYTES + kg * (64 * AK_ROW * 2);
                const unsigned char* vt = lds + 2 * AK2_BYTES + (pr & 1) * AV2_BYTES + kg * 128;
                bf16x8 kf[4][3];
#pragma unroll
                for (int ti = 0; ti < 4; ++ti)
#pragma unroll
                    for (int ks = 0; ks < 3; ++ks) kf[ti][ks] = *(const bf16x8*)(kt + ((16 * ti + li) * AK_ROW + 32 * ks + 8 * lq) * 2);
                f32x4 sc[2][4];
#pragma unroll
                for (int qt = 0; qt < 2; ++qt)
#pragma unroll
                    for (int ti = 0; ti < 4; ++ti) {
                        sc[qt][ti] = (f32x4){0.f, 0.f, 0.f, 0.f};
#pragma unroll
                        for (int ks = 0; ks < 3; ++ks) sc[qt][ti] = __builtin_amdgcn_mfma_f32_16x16x32_bf16(kf[ti][ks], qf[qt][ks], sc[qt][ti], 0, 0, 0);
                    }
                bf16x8 vf[4][2];
#pragma unroll
                for (int dt = 0; dt < 4; ++dt)
#pragma unroll
                    for (int s2 = 0; s2 < 2; ++s2) {
                        const unsigned char* vp = vt + ((16 * dt + li) * AV2_ROW + 32 * s2 + 4 * lq) * 2;
                        const uint2 lo = *(const uint2*)vp, hi = *(const uint2*)(vp + 32);
                        const uint4 w = make_uint4(lo.x, lo.y, hi.x, hi.y);
                        vf[dt][s2] = __builtin_bit_cast(bf16x8, w);
                    }
#pragma unroll
                for (int qt = 0; qt < 2; ++qt) {
                    const int qs = qw + 16 * qt;
                    if (k0 <= qs + 15) {
                        if (k0 + 63 > qs) {
                            const int qpos = qs + li;
#pragma unroll
                            for (int ti = 0; ti < 4; ++ti)
#pragma unroll
                                for (int e = 0; e < 4; ++e) if (k0 + 16 * ti + 4 * lq + e > qpos) sc[qt][ti][e] = -1e30f;
                        }
                        float mx = -1e30f;
#pragma unroll
                        for (int ti = 0; ti < 4; ++ti)
#pragma unroll
                            for (int e = 0; e < 4; ++e) mx = fmaxf(mx, sc[qt][ti][e]);
                        mx = fmaxf(mx, shflx(mx, 16, lane)); mx = fmaxf(mx, shflx(mx, 32, lane));
                        const float mnew = fmaxf(mrun[qt], mx);
                        const float alpha = __builtin_amdgcn_exp2f(mrun[qt] - mnew);
                        float rs = 0.f;
#pragma unroll
                        for (int ti = 0; ti < 4; ++ti)
#pragma unroll
                            for (int e = 0; e < 4; ++e) { const float p = __builtin_amdgcn_exp2f(sc[qt][ti][e] - mnew); sc[qt][ti][e] = p; rs += p; }
                        rs += shflx(rs, 16, lane); rs += shflx(rs, 32, lane);
                        lrun[qt] = lrun[qt] * alpha + rs; mrun[qt] = mnew;
#pragma unroll
                        for (int dt = 0; dt < 4; ++dt) o[qt][dt] = o[qt][dt] * alpha;
                        bf16x8 pb[2];
#pragma unroll
                        for (int s2 = 0; s2 < 2; ++s2) {
                            const unsigned w0 = pk2(sc[qt][2 * s2][0], sc[qt][2 * s2][1]), w1 = pk2(sc[qt][2 * s2][2], sc[qt][2 * s2][3]);
                            const unsigned w2 = pk2(sc[qt][2 * s2 + 1][0], sc[qt][2 * s2 + 1][1]), w3 = pk2(sc[qt][2 * s2 + 1][2], sc[qt][2 * s2 + 1][3]);
                            const uint4 w = make_uint4(w0, w1, w2, w3);
                            pb[s2] = __builtin_bit_cast(bf16x8, w);
                        }
#pragma unroll
                        for (int dt = 0; dt < 4; ++dt)
#pragma unroll
                            for (int s2 = 0; s2 < 2; ++s2) o[qt][dt] = __builtin_amdgcn_mfma_f32_16x16x32_bf16(vf[dt][s2], pb[s2], o[qt][dt], 0, 0, 0);
                    }
                }
            }
            MLA_WRITE((pr + 1) & 1);
            __syncthreads();
        }
#undef MLA_LOAD
#undef MLA_WRITE
        if (kg == 1) {
#pragma unroll
            for (int qt = 0; qt < 2; ++qt) {
                float* mp = mrg + ((qg * 2 + qt) * 18) * 64 + lane;
                mp[0] = mrun[qt]; mp[64] = lrun[qt];
#pragma unroll
                for (int dt = 0; dt < 4; ++dt)
#pragma unroll
                    for (int e = 0; e < 4; ++e) mp[(2 + 4 * dt + e) * 64] = o[qt][dt][e];
            }
        }
        __syncthreads();
        if (kg == 0) {
#pragma unroll
            for (int qt = 0; qt < 2; ++qt) {
                const float* mp = mrg + ((qg * 2 + qt) * 18) * 64 + lane;
                const float m1 = mp[0], l1 = mp[64];
                const float m = fmaxf(mrun[qt], m1);
                const float a0 = __builtin_amdgcn_exp2f(mrun[qt] - m), a1 = __builtin_amdgcn_exp2f(m1 - m);
                const float inv = __builtin_amdgcn_rcpf(lrun[qt] * a0 + l1 * a1);
                GAS bf16_t* op = mixb + (tb + qw + 16 * qt + li) * D + 1472 + h * 64 + 4 * lq;
#pragma unroll
                for (int dt = 0; dt < 4; ++dt) {
                    float v[4];
#pragma unroll
                    for (int e = 0; e < 4; ++e) v[e] = (o[qt][dt][e] * a0 + mp[(2 + 4 * dt + e) * 64] * a1) * inv;
                    stg8((GAS void*)(op + 16 * dt), make_uint2(pk2(v[0], v[1]), pk2(v[2], v[3])));
                }
            }
        }
    }
}


struct Params {
    const float* in[33];
    float* out;
    unsigned char* ws;
};
constexpr int NIN_P = 4352, NQ_P = 1024, NKV_P = 1280;
constexpr size_t al256(size_t x) { return (x + 255) & ~(size_t)255; }
constexpr size_t WS_BAR = 0;
constexpr size_t WS_H = al256(WS_BAR + XCD_BAR_WORDS * 4);
constexpr size_t WS_HN = WS_H + (size_t)T * D * 4;
constexpr size_t WS_Z = WS_HN + (size_t)T * D * 4;
constexpr size_t WS_QM = WS_Z + (size_t)T * DIN * 4;
constexpr size_t WS_KVM = WS_QM + (size_t)T * NQ * 4;
constexpr size_t WS_QF = WS_KVM + (size_t)T * NKV * 4;
constexpr size_t WS_KRF = WS_QF + (size_t)T * NQ * 4;
constexpr size_t WS_QD = WS_KRF + (size_t)T * 32 * 4;
constexpr size_t WS_KD = WS_QD + (size_t)T * DILD * 4;
constexpr size_t WS_OD = WS_KD + (size_t)T * DILD * 4;
constexpr size_t WS_LSE = WS_OD + (size_t)T * DILD * 4;
constexpr size_t WS_X = al256(WS_LSE + (size_t)T * 9 * 4);
constexpr size_t WS_CI = WS_X + (size_t)NB * NG * NCH * 128 * 4;
constexpr size_t WS_GV = WS_CI + (size_t)NB * NG * NCH * 128 * 4;
constexpr size_t WS_CD = WS_GV + (size_t)T * SSMD * 4;
constexpr size_t WS_SD = WS_CD + (size_t)T * 8 * 4;
constexpr size_t WS_CM = WS_SD + (size_t)T * 8 * 4;
constexpr size_t WS_SM = WS_CM + (size_t)T * 16 * 4;
constexpr size_t WS_PPROJ = WS_SM + (size_t)T * 16 * 4;
constexpr size_t WS_EIDX = WS_PPROJ + (size_t)T * D * 4;
constexpr size_t WS_GATE = WS_EIDX + (size_t)T * 2 * 4;
constexpr size_t WS_CNT = WS_GATE + (size_t)T * 2 * 4;
constexpr size_t WS_CURSOR = WS_CNT + 256;
constexpr size_t WS_PSTART = WS_CURSOR + 256;
constexpr size_t WS_TILEE = WS_PSTART + 512;
constexpr size_t WS_SLOTGATE = al256(WS_TILEE + (NTILE + 1) * 4);
constexpr size_t WS_TOKSLOT = WS_SLOTGATE + (size_t)PSLOT * 4;
constexpr size_t WS_AG = WS_TOKSLOT + (size_t)T * 2 * 4;
constexpr size_t WS_ACTB = WS_AG + (size_t)PSLOT * D * 2;
constexpr size_t WS_YB = WS_ACTB + (size_t)PSLOT * FF * 2;
constexpr size_t WS_W1T = WS_YB + (size_t)PSLOT * D * 2;
constexpr size_t WS_W2T = WS_W1T + (size_t)NE * 2 * FF * D * 2;
constexpr size_t WS_HNB = WS_W2T + (size_t)NE * D * FF * 2;
constexpr size_t WS_MIXB = WS_HNB + (size_t)T * D * 2;
constexpr size_t WS_NQB = WS_MIXB + (size_t)T * D * 2;
constexpr size_t WS_NKVB = WS_NQB + (size_t)T * QR * 2;
constexpr size_t WS_GVB = WS_NKVB + (size_t)T * KVR * 2;
constexpr size_t WS_PB = WS_GVB + (size_t)T * GLU_P * 2;
constexpr size_t WS_WIN = WS_PB + (size_t)DEPTH * T * PLE * 2;
constexpr size_t WS_WOUT = WS_WIN + (size_t)DEPTH * NIN_P * D * 2;
constexpr size_t WS_WPG = WS_WOUT + (size_t)DEPTH * D * D * 2;
constexpr size_t WS_WPP = WS_WPG + (size_t)DEPTH * D * D * 2;
constexpr size_t WS_WUQ = WS_WPP + (size_t)DEPTH * D * PLE * 2;
constexpr size_t WS_WUKV = WS_WUQ + (size_t)DEPTH * NQ_P * QR * 2;
constexpr size_t WS_WGLU = WS_WUKV + (size_t)DEPTH * NKV_P * KVR * 2;
constexpr size_t WS_WKT = WS_WGLU + (size_t)DEPTH * GLU_P * GLU_P * 2;
constexpr size_t WS_WVT = WS_WKT + (size_t)DEPTH * 768 * KVR * 2;
constexpr size_t WS_QFB = WS_WVT + (size_t)DEPTH * 768 * KVR * 2;
constexpr size_t WS_KNB = WS_QFB + (size_t)T * NQ * 2;
constexpr size_t WS_KRB = WS_KNB + (size_t)T * KNP * 2;
constexpr size_t WS_VTB = WS_KRB + (size_t)T * 32 * 2;
constexpr size_t WS_W2R = WS_VTB + (size_t)768 * T * 2;
constexpr size_t WS_RSBUF = WS_W2R + (size_t)DEPTH * D * RCOLS * 4;
constexpr size_t WS_SS = WS_RSBUF + (size_t)T * 4;
constexpr size_t WS_RSQ = WS_SS + (size_t)3 * T * 4;
constexpr size_t WS_RSKV = WS_RSQ + (size_t)T * 4;
constexpr size_t WS_HB = WS_RSKV + (size_t)T * 4;
constexpr size_t WS_DQB = WS_HB + (size_t)T * D * 2;
constexpr size_t WS_DKB = WS_DQB + (size_t)T * DILD * 2;
constexpr size_t WS_DVB = WS_DKB + (size_t)T * DILD * 2;
constexpr size_t WS_END = WS_DVB + (size_t)T * DILD * 2;

constexpr int LDS_SCR = 0;
constexpr int LDS_XB = 131072;
constexpr int LDS_INP = LDS_XB + 16;
constexpr int LDS_LG = LDS_INP + 288;
constexpr int LDS_PS = LDS_LG + 2304;
constexpr int LDS_TILEE = LDS_PS + 272;
constexpr int LDS_BYTES = 147456;

__global__ void __launch_bounds__(NTHR, 2) mega(Params P) {
    extern __shared__ __attribute__((aligned(16))) unsigned char smem[];
    uint4* xb_words = (uint4*)(smem + LDS_XB);
    unsigned long long* inp = (unsigned long long*)(smem + LDS_INP);
    float (*As)[132] = (float (*)[132])(smem + LDS_SCR);
    float (*Bs)[68] = (float (*)[68])(smem + LDS_SCR + 16 * 132 * 4);
    float (*lg)[72] = (float (*)[72])(smem + LDS_LG);
    int* ps = (int*)(smem + LDS_PS);
    if (threadIdx.x == 0) {
        *xb_words = make_uint4(0u, 0u, 0u, 0u);
#pragma unroll
        for (int i = 0; i < 33; ++i) inp[i] = (unsigned long long)P.in[i];
        inp[33] = (unsigned long long)P.out;
        inp[34] = (unsigned long long)P.ws;
    }
    __syncthreads();
    const unsigned smem_base = (unsigned)(size_t)(LAS unsigned char*)smem;
#define LDP(i) ({ unsigned b_ = smem_base; asm volatile("" : "+s"(b_)); const unsigned long long v_ = *(LAS unsigned long long*)(b_ + LDS_INP + 8 * (i)); \
        ((unsigned long long)(unsigned)__builtin_amdgcn_readfirstlane((int)(unsigned)v_) | ((unsigned long long)(unsigned)__builtin_amdgcn_readfirstlane((int)(unsigned)(v_ >> 32)) << 32)); })
#define INP(i) ((const float*)LDP(i))
#define WSF(off) ((float*)(LDP(34) + (off)))
#define WSI(off) ((int*)(LDP(34) + (off)))
#define WSB(off) ((bf16_t*)(LDP(34) + (off)))
#define LAUNDER() unsigned z_ = 0u; asm volatile("" : "+s"(z_)); int ws_ = wave_s; asm volatile("" : "+s"(ws_)); int tid_ = (ws_ << 6) | (int)__builtin_amdgcn_mbcnt_hi(~0u, __builtin_amdgcn_mbcnt_lo(~0u, z_)); asm volatile("" : "+v"(tid_)); int bid_ = blockIdx.x; asm volatile("" : "+s"(bid_));
    const int wave_s = __builtin_amdgcn_readfirstlane((int)(threadIdx.x >> 6));
    XcdBarrier bar = xcd_barrier_post((unsigned*)(P.ws + WS_BAR), (volatile LAS unsigned*)(smem + LDS_XB), (int)threadIdx.x);
#define BAR() do { LAUNDER(); XcdBarrier b_; b_.bar = (unsigned*)(LDP(34) + WS_BAR); unsigned bx_ = bar.x; asm volatile("" : "+s"(bx_)); b_.x = bx_; b_.st = bar.st; xcd_barrier(b_, tid_); } while (0)
#define PG8_RUN(MODE, Aptr, Bptr, Mv, Nv, Kv, ldav, ldbv, EPI_INIT) do { LAUNDER(); \
        pg8::Gemm g_{(const bf16_t*)(Aptr), (const bf16_t*)(Bptr), (Mv), (Nv), (Kv), (ldav), (ldbv)}; \
        pg8::StaticOrder S_; S_.init((Mv), (Nv), NBLK, bid_); \
        EpiG<MODE> E_ EPI_INIT; \
        pg8::gemm_phase<EpiG<MODE>, pg8::StaticOrder, true, true>(tid_, (PG8_LAS unsigned char*)(smem + LDS_SCR), g_, S_, E_); } while (0)

    {
        LAUNDER();
        const float* x = INP(0);
        ph_init_rows(tid_, bid_, x, INP(3), WSF(WS_H), WSB(WS_HB), WSF(WS_SS));
        for (long i = GTID(); i < (long)2 * T; i += GSTRIDE()) WSF(WS_SS)[T + i] = 0.f;
        const float* pp = INP(1);
        for (long i = GTID(); i < (long)DEPTH * T * PLE / 2; i += GSTRIDE()) { const float2 v = ((const float2*)pp)[i]; ((unsigned*)WSB(WS_PB))[i] = pk2(v.x, v.y); }
        for (long i = GTID(); i < (long)T * 64; i += GSTRIDE()) WSB(WS_GVB)[(i >> 6) * GLU_P + 448 + (i & 63)] = 0;
    }
    { LAUNDER(); ph_rope_tab(tid_, bid_, (const int*)INP(2), WSF(WS_CD), WSF(WS_SD), WSF(WS_CM), WSF(WS_SM)); }
    {
        LAUNDER();
        for (long i = GTID(); i < (long)DEPTH * D * RCOLS; i += GSTRIDE()) {
            const int Lw = (int)(i / (D * RCOLS)); int r = (int)(i % (D * RCOLS));
            const int j = r & 7; r >>= 3; const int jc = r & 15; r >>= 4; const int q = r & 3; r >>= 2; const int nb = r % 5; r /= 5; const int sst = r & 15, kq4 = r >> 4;
            const int k = 512 * kq4 + 32 * sst + 8 * q + j, col = 16 * nb + jc;
            float v = 0.f;
            if (col < 64) v = INP(24)[(size_t)Lw * D * NE + (size_t)k * NE + col];
            else if (col < 72) v = INP(22)[(size_t)Lw * D * 8 + (size_t)k * 8 + (col - 64)];
            v *= INP(21)[(size_t)Lw * D + k];
            const unsigned hb_ = f2bf(v);
            const unsigned lb_ = f2bf(v - __builtin_bit_cast(float, hb_ << 16));
            bf16_t* dst = (bf16_t*)WSF(WS_W2R) + (size_t)Lw * D * RCOLS * 2;
            const size_t base = ((size_t)((kq4 * 16 + sst) * 5 + nb) * 2) * 512 + (size_t)(16 * q + jc) * 8 + j;
            dst[base] = (bf16_t)hb_; dst[base + 512] = (bf16_t)lb_;
        }
    }
    {
        LAUNDER();
        const int wave = tid_ >> 6, lane = tid_ & 63;
        const int gw = bid_ * 8 + wave, NGW = NBLK * 8;
        constexpr int I_IN = (D / 64) * (DIN / 32), I_OUT = (D / 64) * (D / 32), I_PG = I_OUT, I_PP = (PLE / 64) * (D / 32),
                      I_UQ = (QR / 64) * (NQ / 32), I_GLU = (SSMD / 64) * (SSMD / 32);
        constexpr int I_LAYER = I_IN + I_OUT + I_PG + I_PP + I_UQ + I_GLU;
        for (int it = gw; it < DEPTH * I_LAYER; it += NGW) {
            const int L = it / I_LAYER; int r = it % I_LAYER;
            if (r < I_IN) { const int nbk = DIN / 32; tr_reg(INP(4) + (size_t)L * D * DIN, DIN, 64 * (r / nbk), 32 * (r % nbk), WSB(WS_WIN) + (size_t)L * NIN_P * D, 32 * (r % nbk), D, lane); continue; } r -= I_IN;
            if (r < I_OUT) { const int nbk = D / 32; tr_reg(INP(20) + (size_t)L * D * D, D, 64 * (r / nbk), 32 * (r % nbk), WSB(WS_WOUT) + (size_t)L * D * D, 32 * (r % nbk), D, lane); continue; } r -= I_OUT;
            if (r < I_PG) { const int nbk = D / 32; tr_reg(INP(31) + (size_t)L * D * D, D, 64 * (r / nbk), 32 * (r % nbk), WSB(WS_WPG) + (size_t)L * D * D, 32 * (r % nbk), D, lane); continue; } r -= I_PG;
            if (r < I_PP) { const int nbk = D / 32; tr_reg(INP(30) + (size_t)L * PLE * D, D, 64 * (r / nbk), 32 * (r % nbk), WSB(WS_WPP) + (size_t)L * D * PLE, 32 * (r % nbk), PLE, lane); continue; } r -= I_PP;
            if (r < I_UQ) { const int nbk = NQ / 32; tr_reg(INP(17) + (size_t)L * QR * NQ, NQ, 64 * (r / nbk), 32 * (r % nbk), WSB(WS_WUQ) + (size_t)L * NQ_P * QR, 32 * (r % nbk), QR, lane, INP(16) + (size_t)L * QR); continue; } r -= I_UQ;
            { const int nbk = SSMD / 32; tr_reg(INP(14) + (size_t)L * SSMD * SSMD, SSMD, 64 * (r / nbk), 32 * (r % nbk), WSB(WS_WGLU) + (size_t)L * GLU_P * GLU_P, 32 * (r % nbk), GLU_P, lane); }
        }
        for (int it = gw; it < DEPTH * 2 * 4 * 18; it += NGW) {
            const int L = it / 144, r = it % 144, sel = r / 72, kb = (r % 72) / 18, nbp = r % 18, h = nbp >> 1, d0 = (nbp & 1) * 32;
            tr_reg(INP(19) + (size_t)L * KVR * NKV, NKV, 64 * kb, h * 128 + sel * 64 + d0, WSB(sel ? WS_WVT : WS_WKT) + (size_t)L * 768 * KVR, 32 * nbp, KVR, lane, INP(18) + (size_t)L * KVR);
        }
        for (long i = GTID(); i < (long)DEPTH * 2 * 192 * KVR / 8; i += GSTRIDE()) {
            const int per = 192 * KVR / 8; const int m = (int)(i / per), w = (int)(i % per);
            *(uint4*)(WSB(WS_WKT) + (size_t)m * 768 * KVR + (size_t)576 * KVR + (size_t)w * 8) = make_uint4(0, 0, 0, 0);
        }
    }
    BAR();
    for (int L0 = 0; L0 < DEPTH; ++L0) {
#define L ({ int l_ = L0; asm volatile("" : "+s"(l_)); l_; })
        { LAUNDER(); if (bid_ == 0 && tid_ < NE) { WSI(WS_CNT)[tid_] = 0; WSI(WS_CURSOR)[tid_] = 0; } }
        {
            LAUNDER();
            pg8::Gemm g_{WSB(WS_HB), WSB(WS_WIN) + (size_t)L * NIN_P * D, T, 4096, D, D, D};
            pg8::StaticOrder S_; S_.init(T, 4096, NBLK, bid_);
            EpiZ E_{WSB(WS_Z), DIN, 4096, WSF(WS_SS) + (size_t)L * T, wave_s};
            pg8::gemm_phase<EpiZ, pg8::StaticOrder, true, true>(tid_, (PG8_LAS unsigned char*)(smem + LDS_SCR), g_, S_, E_);
        }
        { LAUNDER(); ph_thin_win(tid_, bid_, WSB(WS_HB), WSB(WS_WIN) + (size_t)L * NIN_P * D, WSF(WS_SS) + (size_t)L * T, WSB(WS_Z), smem + LDS_SCR); }
        PG8_RUN(5, WSB(WS_PB) + (size_t)L * T * PLE, WSB(WS_WPP) + (size_t)L * D * PLE, T, D, PLE, PLE, PLE, ({nullptr, D, D, nullptr, 0, nullptr, (bf16_t*)WSF(WS_PPROJ), D, wave_s}));
        BAR();
        { LAUNDER(); ph_light(tid_, bid_, WSB(WS_Z), INP(5) + (size_t)L * 3 * CONVD, WSF(WS_CD), WSF(WS_SD), WSF(WS_CM), WSF(WS_SM), WSB(WS_MIXB), WSF(WS_RSQ), WSF(WS_RSKV)); }
        { LAUNDER(); ph_ssm_local(tid_, bid_, WSB(WS_Z), INP(6) + (size_t)L * NG * NP, INP(7) + (size_t)L * NG * NP, INP(8) + (size_t)L * NG,
                                  INP(9) + (size_t)L * NG * NP * 16, INP(10) + (size_t)L * NG * NP * 16, WSF(WS_X), smem + LDS_SCR); }
        BAR();
        { LAUNDER(); ph_dil_attn_mfma(tid_, bid_, WSB(WS_Z), WSF(WS_OD), WSF(WS_LSE), smem + LDS_SCR); }
        {
            LAUNDER();
            if (bid_ < 128) {
            pg8::Gemm g_{WSB(WS_Z) + OFF_CQ, WSB(WS_WUQ) + (size_t)L * NQ_P * QR, T, NQ_P, QR, DIN, QR};
            pg8::StaticOrder S_; S_.init(T, NQ_P, 128, bid_);
            EpiB16S E_{WSB(WS_QFB), NQ, NQ, WSF(WS_RSQ), nullptr, 0.10206207261596575f * 1.4426950408889634f, wave_s};
            pg8::gemm_phase<EpiB16S, pg8::StaticOrder, true, true>(tid_, (PG8_LAS unsigned char*)(smem + LDS_SCR), g_, S_, E_);
            }
        }
        {
            LAUNDER();
            if (bid_ >= 128 && bid_ < 192) {
            pg8::Gemm g_{WSB(WS_Z) + OFF_CKV, WSB(WS_WKT) + (size_t)L * 768 * KVR, T, 768, KVR, DIN, KVR};
            pg8::StaticOrder S_; S_.init(T, 768, 64, bid_ - 128);
            EpiB16S E_{WSB(WS_KNB), KNP, KNP, WSF(WS_RSKV), nullptr, 1.f, wave_s};
            pg8::gemm_phase<EpiB16S, pg8::StaticOrder, true, true>(tid_, (PG8_LAS unsigned char*)(smem + LDS_SCR), g_, S_, E_);
            }
        }
        {
            LAUNDER();
            if (bid_ >= 192) {
            pg8::Gemm g_{WSB(WS_WVT) + (size_t)L * 768 * KVR, WSB(WS_Z) + OFF_CKV, 768, T, KVR, KVR, DIN};
            pg8::StaticOrder S_; S_.init(768, T, 64, bid_ - 192);
            EpiB16S E_{WSB(WS_VTB), T, T, nullptr, WSF(WS_RSKV), 1.f, wave_s};
            pg8::gemm_phase<EpiB16S, pg8::StaticOrder, true, true>(tid_, (PG8_LAS unsigned char*)(smem + LDS_SCR), g_, S_, E_);
            }
        }
        { LAUNDER(); ph_ssm_final(tid_, bid_, WSB(WS_Z), INP(6) + (size_t)L * NG * NP, INP(7) + (size_t)L * NG * NP, INP(8) + (size_t)L * NG,
                                  INP(9) + (size_t)L * NG * NP * 16, INP(10) + (size_t)L * NG * NP * 16, INP(11) + (size_t)L * NG * 16 * NP, INP(12) + (size_t)L * NG * 16 * NP,
                                  INP(13) + (size_t)L * SSMD, WSF(WS_X), WSF(WS_GV), WSB(WS_GVB), smem + LDS_SCR); }
        BAR();
        {
            LAUNDER();
            if (bid_ >= 192) {
            pg8::Gemm g_{WSB(WS_GVB), WSB(WS_WGLU) + (size_t)L * GLU_P * GLU_P, T, GLU_P, GLU_P, GLU_P, GLU_P};
            pg8::StaticOrder S_; S_.init(T, GLU_P, 64, bid_ - 192);
            EpiG<4> E_({nullptr, 0, SSMD, WSF(WS_GV), SSMD, INP(15) + (size_t)L * SSMD, WSB(WS_MIXB) + 448, D, wave_s});
            pg8::gemm_phase<EpiG<4>, pg8::StaticOrder, true, true>(tid_, (PG8_LAS unsigned char*)(smem + LDS_SCR), g_, S_, E_);
            }
        }
        { LAUNDER(); ph_dil_combine(tid_, bid_, WSF(WS_OD), WSF(WS_LSE), WSB(WS_MIXB)); }
        { LAUNDER(); ph_mla_attn_mfma(tid_, bid_, WSB(WS_QFB), WSB(WS_KNB), WSB(WS_Z), WSB(WS_VTB), WSB(WS_MIXB), WSF(WS_CM), WSF(WS_SM), smem + LDS_SCR); }
        BAR();
        PG8_RUN(1, WSB(WS_MIXB), WSB(WS_WOUT) + (size_t)L * D * D, T, D, D, D, D, ({WSF(WS_H), D, D, nullptr, 0, nullptr, nullptr, 0, wave_s}));
        BAR();
        { LAUNDER(); ph_router_mfma(tid_, bid_, WSF(WS_H), WSF(WS_W2R) + (size_t)L * D * RCOLS, INP(23) + (size_t)L * 8, INP(25) + (size_t)L * NE,
                                    WSI(WS_EIDX), WSF(WS_GATE), WSF(WS_RSBUF), WSI(WS_CNT), smem + LDS_SCR); }
        BAR();
        { LAUNDER(); ph_moe_scatter(tid_, bid_, WSI(WS_EIDX), WSF(WS_GATE), WSI(WS_CNT), WSI(WS_CURSOR), WSF(WS_H), WSF(WS_RSBUF), INP(21) + (size_t)L * D,
                                    WSB(WS_AG), WSF(WS_SLOTGATE), WSI(WS_TOKSLOT), ps, (int*)(smem + LDS_TILEE)); }
        BAR();
        {
            LAUNDER();
            moe_gemm<1>(tid_, bid_, (const LAS int*)(smem_base + LDS_TILEE), WSB(WS_AG), D, D, INP(26) + (size_t)L * NE * D * FF, INP(27) + (size_t)L * NE * D * FF,
                        WSB(WS_ACTB), nullptr, (PG8_LAS unsigned char*)(smem + LDS_SCR));
        }
        BAR();
        {
            LAUNDER();
            moe_gemm<2>(tid_, bid_, (const LAS int*)(smem_base + LDS_TILEE), WSB(WS_ACTB), FF, FF, INP(28) + (size_t)L * NE * FF * D, nullptr,
                        WSB(WS_YB), WSF(WS_SLOTGATE), (PG8_LAS unsigned char*)(smem + LDS_SCR));
        }
        BAR();
        { LAUNDER(); ph_moe_combine_norm(tid_, bid_, WSF(WS_H), WSB(WS_YB), WSI(WS_TOKSLOT), INP(29) + (size_t)L * D, WSB(WS_HNB)); }
        BAR();
        {
            LAUNDER();
            pg8::Gemm g_{WSB(WS_HNB), WSB(WS_WPG) + (size_t)L * D * D, T, D, D, D, D};
            pg8::StaticOrder S_; S_.init(T, D, NBLK, bid_);
            EpiPle E_{WSF(WS_H), (const bf16_t*)WSF(WS_PPROJ), (L0 == 0) ? (INP(3) + D) : INP(32), WSB(WS_HB), WSF(WS_SS) + (size_t)(L + 1) * T, wave_s};
            pg8::gemm_phase<EpiPle, pg8::StaticOrder, true, true>(tid_, (PG8_LAS unsigned char*)(smem + LDS_SCR), g_, S_, E_);
        }
        BAR();
    }
#undef L
    { LAUNDER(); ph_final_norm(tid_, bid_, WSF(WS_H), WSF(WS_SS) + (size_t)2 * T, INP(32), (float*)LDP(33)); }
}
}

extern "C" void kernel_launch(void* const* d_in, const int* in_sizes, int n_in, void* d_out, int out_size, void* d_ws, size_t ws_size,
                              hipStream_t stream) {
    static int grid = 0;
    if (!grid) {
        int dev = 0, cus = 0, per_cu = 0;
        (void)hipGetDevice(&dev);
        (void)hipDeviceGetAttribute(&cus, hipDeviceAttributeMultiprocessorCount, dev);
        if (hipFuncSetAttribute((const void*)mega, hipFuncAttributeMaxDynamicSharedMemorySize, LDS_BYTES) != hipSuccess) fprintf(stderr, "hipFuncSetAttribute failed\n");
        (void)hipOccupancyMaxActiveBlocksPerMultiprocessor(&per_cu, (const void*)mega, NTHR, LDS_BYTES);
        if (per_cu < 1) fprintf(stderr, "occupancy query returned %d\n", per_cu);
        (void)hipGetLastError();
        grid = NBLK;
        if (cus != NBLK) fprintf(stderr, "expected %d CUs, got %d\n", NBLK, cus);
    }
    Params P{};
    for (int i = 0; i < 33; ++i) P.in[i] = (const float*)d_in[i];
    P.out = (float*)d_out;
    P.ws = (unsigned char*)d_ws;
    if (ws_size < WS_END) fprintf(stderr, "ws too small: %zu < %zu\n", ws_size, (size_t)WS_END);
    (void)hipMemsetAsync((char*)d_ws + WS_BAR, 0, XCD_BAR_WORDS * 4, stream);
    hipLaunchKernelGGL(mega, dim3(grid), dim3(NTHR), LDS_BYTES, stream, P);
}
```
